# Optimizing an MI355X kernel written in HIP

```python
import jax, jax.numpy as jnp
from jax import lax
import numpy as np

D_MODEL = 2048
BATCH = 4
SEQ = 2048
DEPTH = 2

MIX_WIDTH = D_MODEL
N_MIXERS = 4
GROUP_WIDTH = MIX_WIDTH // N_MIXERS
GMLP_CHUNK = 128
GMLP_GROUPS = 8
GMLP_GROUP_DIM = GROUP_WIDTH // GMLP_GROUPS
DIFF_HEAD_DIM = 64
DIFF_HEADS = GROUP_WIDTH // (2 * DIFF_HEAD_DIM)
ATTN_BLOCK = 128
DIL_HEAD_DIM = 64
DIL_HEADS = GROUP_WIDTH // DIL_HEAD_DIM
DIL_PATTERNS = ((128, 1), (512, 4), (2048, 16))
CONV_WIDTH = 31
CONV_CH = GROUP_WIDTH
D_FF = 4 * D_MODEL
N_IN_SPLITS = 10
IN_WIDTH = N_IN_SPLITS * GROUP_WIDTH
N_ALIBI_HEADS = DIFF_HEADS + DIL_HEADS
NORM_EPS = 1e-6

kernel_name = "hybrid_parallel_gmlp_diffattn_dilated_conformer"


def rmsnorm(x, g):
    xf = x.astype(jnp.float32)
    y = xf * lax.rsqrt(jnp.mean(xf * xf, axis=-1, keepdims=True) + NORM_EPS)
    return (y * g.astype(jnp.float32)).astype(x.dtype)


def layernorm_noparam(x):
    xf = x.astype(jnp.float32)
    mu = jnp.mean(xf, axis=-1, keepdims=True)
    xc = xf - mu
    y = xc * lax.rsqrt(jnp.mean(xc * xc, axis=-1, keepdims=True) + NORM_EPS)
    return y.astype(x.dtype)


def alibi_slopes():
    i = jnp.arange(1, N_ALIBI_HEADS + 1, dtype=jnp.float32)
    s = 2.0 ** (-8.0 * i / N_ALIBI_HEADS)
    diff_idx = np.arange(0, N_ALIBI_HEADS, 3)
    dil_idx = np.array([j for j in range(N_ALIBI_HEADS) if j % 3 != 0])
    return s[diff_idx], s[dil_idx]


def gmlp_mixer(u, v, w_s, b_s):
    B, S, _ = u.shape
    u = jax.nn.gelu(u)
    v = layernorm_noparam(jax.nn.gelu(v))
    nc = S // GMLP_CHUNK
    vc = v.reshape(B, nc, GMLP_CHUNK, GMLP_GROUPS, GMLP_GROUP_DIM)
    causal = jnp.tril(jnp.ones((GMLP_CHUNK, GMLP_CHUNK), dtype=bool))
    w = jnp.where(causal[None], w_s, jnp.zeros_like(w_s))
    z = jnp.einsum('gts,bcsgd->bctgd', w, vc) + b_s.T[None, None, :, :, None]
    return u * z.reshape(B, S, GROUP_WIDTH)


def diff_attention(q, k, v, lam, lam_init, subln_g, slopes):
    B, S = q.shape[:2]
    nb = S // ATTN_BLOCK
    scale = DIFF_HEAD_DIM ** -0.5
    key_pos = jnp.arange(S)
    qb = q.reshape(B, nb, ATTN_BLOCK, DIFF_HEADS, 2, DIFF_HEAD_DIM).transpose(1, 0, 2, 3, 4, 5)

    def block(args):
        qi, start = args
        s = jnp.einsum('bqhcd,bkhcd->bhcqk', qi, k).astype(jnp.float32) * scale
        dist = (start + jnp.arange(ATTN_BLOCK))[:, None] - key_pos[None, :]
        bias = -slopes[:, None, None, None] * dist.astype(jnp.float32)
        s = jnp.where(dist >= 0, s + bias, -jnp.inf)
        p = jax.nn.softmax(s, axis=-1)
        a = p[:, :, 0] - lam * p[:, :, 1]
        return jnp.einsum('bhqk,bkhe->bqhe', a.astype(v.dtype), v)

    o = lax.map(block, (qb, jnp.arange(nb) * ATTN_BLOCK))
    o = o.transpose(1, 0, 2, 3, 4).reshape(B, S, DIFF_HEADS, 2 * DIFF_HEAD_DIM)
    o = rmsnorm(o, subln_g) * (1.0 - lam_init)
    return o.reshape(B, S, GROUP_WIDTH)


def dilated_attention(q, k, v, slopes):
    B, S, H, dh = q.shape
    scale = dh ** -0.5
    results = []
    for window, dil in DIL_PATTERNS:
        n = window // dil
        seg = n * dil
        sp = -(-S // seg) * seg
        nb = sp // seg

        def to_classes(t):
            t = jnp.pad(t, ((0, 0), (0, sp - S), (0, 0), (0, 0)))
            t = t.reshape(B, sp // dil, dil, H, dh).transpose(0, 2, 3, 1, 4)
            return t.reshape(B, dil, H, nb, n, dh)

        def with_prev(t):
            prev = jnp.pad(t, ((0, 0), (0, 0), (0, 0), (1, 0), (0, 0), (0, 0)))[:, :, :, :-1]
            return jnp.concatenate([prev, t], axis=4)

        def from_classes(t):
            e = t.shape[-1]
            t = t.reshape(B, dil, H, sp // dil, e).transpose(0, 3, 1, 2, 4).reshape(B, sp, H, e)
            return t[:, :S]

        qc = to_classes(q)
        kb = with_prev(to_classes(k))
        vb = with_prev(to_classes(v))
        s = jnp.einsum('brhcqd,brhckd->brhcqk', qc, kb).astype(jnp.float32) * scale
        step = n + jnp.arange(n)[:, None] - jnp.arange(2 * n)[None, :]
        has_key = (jnp.arange(nb)[:, None, None] > 0) | (jnp.arange(2 * n)[None, None, :] >= n)
        valid = (step >= 0) & (step <= n) & has_key
        bias = -slopes[:, None, None, None] * (step * dil).astype(jnp.float32)
        s = jnp.where(valid, s + bias, -jnp.inf)
        m = jnp.max(s, axis=-1, keepdims=True)
        p = jnp.exp(s - m)
        l = jnp.sum(p, axis=-1, keepdims=True)
        o = jnp.einsum('brhcqk,brhckd->brhcqd', p.astype(v.dtype), vb).astype(jnp.float32)
        results.append((from_classes(m), from_classes(l), from_classes(o)))
    m_all = results[0][0]
    for m_i, _, _ in results[1:]:
        m_all = jnp.maximum(m_all, m_i)
    num = sum(jnp.exp(m_i - m_all) * o_i for m_i, _, o_i in results)
    den = sum(jnp.exp(m_i - m_all) * l_i for m_i, l_i, _ in results)
    return (num / den).astype(q.dtype).reshape(B, S, GROUP_WIDTH)


def conformer_conv(a, gate, w_dw, b_dw, norm_g):
    h = a * jax.nn.sigmoid(gate)
    h = lax.conv_general_dilated(
        h, w_dw[:, None, :].astype(h.dtype), window_strides=(1,), padding=[(CONV_WIDTH - 1, 0)],
        dimension_numbers=('NWC', 'WIO', 'NWC'), feature_group_count=CONV_CH)
    h = rmsnorm(h + b_dw, norm_g)
    return jax.nn.silu(h)


def setup_inputs(seed: int = 0) -> dict:
    key = jax.random.key(seed)
    ks = jax.random.split(key, 20)
    L, f32 = DEPTH, jnp.float32
    nrm = lambda k, shape, scale: jax.random.normal(k, shape, f32) * scale
    gain = lambda k, shape: 1.0 + 0.1 * jax.random.normal(k, shape, f32)
    return {
        "x": jax.random.normal(ks[0], (BATCH, SEQ, D_MODEL), f32),
        "g_mix_pre": gain(ks[1], (L, D_MODEL)),
        "g_mix_post": gain(ks[2], (L, D_MODEL)),
        "w_in": nrm(ks[3], (L, D_MODEL, IN_WIDTH), D_MODEL ** -0.5),
        "gmlp_w": nrm(ks[4], (L, GMLP_GROUPS, GMLP_CHUNK, GMLP_CHUNK), GMLP_CHUNK ** -0.5),
        "gmlp_b": gain(ks[5], (L, GMLP_GROUPS, GMLP_CHUNK)),
        "diff_lam": nrm(ks[6], (L, 4, DIFF_HEAD_DIM), 0.1),
        "diff_subln": gain(ks[7], (L, 2 * DIFF_HEAD_DIM)),
        "conv_w": nrm(ks[8], (L, CONV_WIDTH, CONV_CH), CONV_WIDTH ** -0.5),
        "conv_b": nrm(ks[9], (L, CONV_CH), 0.02),
        "conv_norm": gain(ks[10], (L, CONV_CH)),
        "w_out": nrm(ks[11], (L, MIX_WIDTH, D_MODEL), MIX_WIDTH ** -0.5),
        "g_ffn_pre": gain(ks[12], (L, D_MODEL)),
        "g_ffn_post": gain(ks[13], (L, D_MODEL)),
        "w_ff1": nrm(ks[14], (L, D_MODEL, D_FF), D_MODEL ** -0.5),
        "w_ff2": nrm(ks[15], (L, D_FF, D_MODEL), D_FF ** -0.5),
    }


def reference(x, g_mix_pre, g_mix_post, w_in, gmlp_w, gmlp_b, diff_lam, diff_subln,
              conv_w, conv_b, conv_norm, w_out, g_ffn_pre, g_ffn_post, w_ff1, w_ff2):
    B, S, _ = x.shape
    slopes_diff, slopes_dil = alibi_slopes()
    for li in range(DEPTH):
        h = rmsnorm(x, g_mix_pre[li])
        proj = jnp.einsum('bsd,de->bse', h, w_in[li])
        a_u, a_v, b_q, b_k, b_v, c_q, c_k, c_v, d_a, d_g = jnp.split(proj, N_IN_SPLITS, axis=-1)

        out_a = gmlp_mixer(a_u, a_v, gmlp_w[li], gmlp_b[li])

        lam_init = 0.8 - 0.6 * float(np.exp(-0.3 * li))
        lp = diff_lam[li].astype(jnp.float32)
        lam = jnp.exp(jnp.sum(lp[0] * lp[1])) - jnp.exp(jnp.sum(lp[2] * lp[3])) + lam_init
        out_b = diff_attention(
            b_q.reshape(B, S, DIFF_HEADS, 2, DIFF_HEAD_DIM),
            b_k.reshape(B, S, DIFF_HEADS, 2, DIFF_HEAD_DIM),
            b_v.reshape(B, S, DIFF_HEADS, 2 * DIFF_HEAD_DIM),
            lam, lam_init, diff_subln[li], slopes_diff)

        out_c = dilated_attention(
            c_q.reshape(B, S, DIL_HEADS, DIL_HEAD_DIM),
            c_k.reshape(B, S, DIL_HEADS, DIL_HEAD_DIM),
            c_v.reshape(B, S, DIL_HEADS, DIL_HEAD_DIM),
            slopes_dil)

        out_d = conformer_conv(d_a, d_g, conv_w[li], conv_b[li], conv_norm[li])

        mixed = jnp.concatenate([out_a, out_b, out_c, out_d], axis=-1)
        x = x + rmsnorm(jnp.einsum('bse,ed->bsd', mixed, w_out[li]), g_mix_post[li])

        h = rmsnorm(x, g_ffn_pre[li])
        f = jnp.square(jax.nn.relu(jnp.einsum('bsd,df->bsf', h, w_ff1[li])))
        x = x + rmsnorm(jnp.einsum('bsf,fd->bsd', f, w_ff2[li]), g_ffn_post[li])
    return x
```

```cpp
#include <hip/hip_runtime.h>
#include <hip/hip_cooperative_groups.h>
#include <cstdio>
#include <cstdint>
namespace cg = cooperative_groups;

#ifndef MK_N_LAUNCHES
#define MK_N_LAUNCHES 1
#endif

namespace pg8 {
#define PG8_LAS __attribute__((address_space(3)))
typedef unsigned short bf16_t;
typedef short bf16x8 __attribute__((ext_vector_type(8)));
typedef float f32x4 __attribute__((ext_vector_type(4)));
typedef unsigned u32x4 __attribute__((ext_vector_type(4)));
constexpr int BM = 256, BK = 64, HALF = 128, HTB = HALF * BK * 2  , STAGE_BYTES = 8 * HTB, NXCD = 8, WGM = 8;

__host__ __device__ __forceinline__ int lds_byte(int r, int c) { const int st = (r >> 4) * 2 + (c >> 5), rr = r & 15, cc = c & 31, ob = rr * 64 + cc * 2; return st * 1024 + (ob ^ (((ob >> 9) & 1) << 5)); }
__host__ __device__ __forceinline__ void stage_rc(int b, int& R, int& C) { const int st = b / 1024, sb = b % 1024, swz = sb ^ (((sb >> 9) & 1) << 5); R = (st >> 1) * 16 + swz / 64; C = (st & 1) * 32 + (swz % 64) / 2; }
__host__ __device__ __forceinline__ int perm32(int rho) { const int n = rho >> 4, i = rho & 15; return 8 * (i >> 2) + 4 * n + (i & 3); }

struct Unit { int pm, pn; };
struct Gemm { const bf16_t* A; const bf16_t* Bt; int M, N, K; };

struct StaticOrder {
    int nM, nN, nwg, G, c;
    __host__ __device__ void init(int M, int N, int G_, int c_) { nM = M / BM; nN = N / BM; nwg = nM * nN; G = G_; c = c_; }
    __host__ __device__ bool next(int i, Unit& u) const {
        const long L = (long)i * G + c; if (L >= nwg) return false;
        int wgid = (int)L; { const int q = nwg / NXCD, r = nwg % NXCD, xcd = wgid % NXCD, off = wgid / NXCD; wgid = (xcd < r ? xcd * (q + 1) : r * (q + 1) + (xcd - r) * q) + off; }
        const int nig = WGM * nN, gid = wgid / nig, fm = gid * WGM, gsz = (nM - fm) < WGM ? (nM - fm) : WGM;
        u.pm = fm + ((wgid % nig) % gsz); u.pn = (wgid % nig) / gsz; return true;
    }
    __device__ __forceinline__ void a_ready(const Unit&) const {}
    __device__ __forceinline__ void done(const Unit&) const {}
};

__device__ __forceinline__ unsigned cvt_pk_bf16(float lo, float hi) { unsigned r; asm volatile("v_cvt_pk_bf16_f32 %0, %1, %2" : "=v"(r) : "v"(lo), "v"(hi)); return r; }

struct EpiRowScaleBf16 {
    static constexpr bool PERM = true, AFTER_DRAIN = false;
    bf16_t* O; int ldc; const float* rinv; int act;
    __device__ __forceinline__ void operator()(const f32x4 (&acc)[2][2][4][2], const Unit& u, int wr, int wc, int fr, int fq) const {
        const int row0 = u.pm * BM + wr * 64 + fr; const int col0 = u.pn * BM + wc * 32 + 8 * fq;
#pragma unroll
        for (int ai = 0; ai < 2; ++ai)
#pragma unroll
            for (int m = 0; m < 4; ++m) { const int row = row0 + ai * HALF + m * 16; const float s = rinv[row]; bf16_t* rowp = O + (size_t)row * ldc + col0;
#pragma unroll
                for (int bj = 0; bj < 2; ++bj) { f32x4 v0 = acc[ai][bj][m][0] * s, v1 = acc[ai][bj][m][1] * s;
                    if (act) {
#pragma unroll
                        for (int e = 0; e < 4; ++e) { const float a = fmaxf(v0[e], 0.f), b = fmaxf(v1[e], 0.f); v0[e] = a * a; v1[e] = b * b; } }
                    u32x4 w; w.x = cvt_pk_bf16(v0[0], v0[1]); w.y = cvt_pk_bf16(v0[2], v0[3]); w.z = cvt_pk_bf16(v1[0], v1[1]); w.w = cvt_pk_bf16(v1[2], v1[3]);
                    *(u32x4*)(rowp + bj * HALF) = w; } }
    }
};
struct EpiF32Ssq {
    static constexpr bool PERM = false, AFTER_DRAIN = false;
    float* Y; int ldc; float* ssq;
    __device__ __forceinline__ void operator()(const f32x4 (&acc)[2][2][4][2], const Unit& u, int wr, int wc, int fr, int fq) const {
        const int row0 = u.pm * BM + wr * 64 + fr; const int col0 = u.pn * BM + wc * 32 + 4 * fq;
#pragma unroll
        for (int ai = 0; ai < 2; ++ai)
#pragma unroll
            for (int m = 0; m < 4; ++m) { const int row = row0 + ai * HALF + m * 16; float* rowp = Y + (size_t)row * ldc + col0; float s = 0.f;
#pragma unroll
                for (int bj = 0; bj < 2; ++bj)
#pragma unroll
                    for (int n = 0; n < 2; ++n) { const f32x4 v = acc[ai][bj][m][n]; s += (v[0] * v[0] + v[1] * v[1]) + (v[2] * v[2] + v[3] * v[3]); *(f32x4*)(rowp + bj * HALF + n * 16) = v; }
                s += __shfl_xor(s, 16); s += __shfl_xor(s, 32);
                if (fq == 0) ssq[(size_t)row * 32 + u.pn * 4 + wc] = s; }
    }
};

template <class Epi, class Sched, bool ALIGN_EPI = false, bool SP2 = false>
__device__ __forceinline__ void gemm_phase(PG8_LAS unsigned char* lds, const Gemm g, const Sched& S, const Epi& E, const int tid) {
    const int wid = __builtin_amdgcn_readfirstlane(tid >> 6), lane = tid & 63, wr = wid >> 2, wc = wid & 3, fr = lane & 15, fq = lane >> 4;
    const int K = g.K, nt = K / BK;
    unsigned voffA[2], voffB[2];
#pragma unroll
    for (int i = 0; i < 2; ++i) { int R, C; stage_rc(tid * 16 + i * 8192, R, C); const int Rb = Epi::PERM ? ((R & ~31) + perm32(R & 31)) : R;
        voffA[i] = (unsigned)(R * K + C) * 2u; voffB[i] = (unsigned)(Rb * K + C) * 2u; }
    const size_t kstep = (size_t)(BK * 2);
    const size_t hstep = (size_t)HALF * K * 2;
    const size_t tstep = 2 * hstep;
    const unsigned ldsw = (unsigned)wid * 1024u;
    const int aoff = lds_byte(wr * 64 + fr, fq * 8), boff = lds_byte(wc * 32 + fr, fq * 8);
#define PG8_SA(b, h) (((b) * 2 + (h)) * HTB)
#define PG8_SB(b, h) ((4 + (b) * 2 + (h)) * HTB)
#define PG8_STAGE(bufoff, gbase, voff) do { _Pragma("unroll") for (int _i = 0; _i < 2; ++_i) \
        __builtin_amdgcn_global_load_lds((const unsigned*)((const char*)(gbase) + (voff)[_i]), (PG8_LAS unsigned*)(lds + (bufoff) + ldsw + _i * 8192), 16, 0, 0); } while (0)
#define PG8_LDA(dst, b, h) do { _Pragma("unroll") for (int m = 0; m < 4; ++m) _Pragma("unroll") for (int k = 0; k < 2; ++k) dst[m][k] = *(const PG8_LAS bf16x8*)(lds + PG8_SA(b, h) + aoff + m * 2048 + k * 1024); } while (0)
#define PG8_LDB(dst, b, h) do { _Pragma("unroll") for (int n = 0; n < 2; ++n) _Pragma("unroll") for (int k = 0; k < 2; ++k) dst[n][k] = *(const PG8_LAS bf16x8*)(lds + PG8_SB(b, h) + boff + n * 2048 + k * 1024); } while (0)
#define PG8_MMA(ai, bj, At, Bt) do { __builtin_amdgcn_s_setprio(1); _Pragma("unroll") for (int m = 0; m < 4; ++m) _Pragma("unroll") for (int n = 0; n < 2; ++n) _Pragma("unroll") for (int k = 0; k < 2; ++k) \
        acc[ai][bj][m][n] = __builtin_amdgcn_mfma_f32_16x16x32_bf16(Bt[n][k], At[m][k], acc[ai][bj][m][n], 0, 0, 0); __builtin_amdgcn_s_setprio(0); } while (0)
#define PG8_WAIT_V(n) asm volatile("s_waitcnt vmcnt(" #n ")" ::: "memory")
#define PG8_WAIT_L(n) asm volatile("s_waitcnt lgkmcnt(" #n ")" ::: "memory")
#define PG8_BAR __builtin_amdgcn_s_barrier()
#define PG8_SCHED __builtin_amdgcn_sched_barrier(0)
    Unit cur, nxt; int ui = 0;
    if (!S.next(0, cur)) return;
    f32x4 acc[2][2][4][2];
#pragma unroll
    for (int a = 0; a < 2; ++a)
#pragma unroll
        for (int b = 0; b < 2; ++b)
#pragma unroll
            for (int m = 0; m < 4; ++m)
#pragma unroll
                for (int n = 0; n < 2; ++n) acc[a][b][m][n] = (f32x4){0.f, 0.f, 0.f, 0.f};
    bf16x8 At[4][2], B0[2][2], B1[2][2];
    const char* cA = (const char*)g.A + (size_t)cur.pm * tstep; const char* cB = (const char*)g.Bt + (size_t)cur.pn * tstep;
    S.a_ready(cur);
    if constexpr (SP2) {
        PG8_STAGE(PG8_SB(0, 0), cB, voffB); PG8_STAGE(PG8_SB(0, 1), cB + hstep, voffB); PG8_STAGE(PG8_SA(0, 0), cA, voffA); PG8_STAGE(PG8_SA(0, 1), cA + hstep, voffA);
        if (wr == 1) PG8_BAR;
        PG8_WAIT_V(2); PG8_BAR;
        PG8_STAGE(PG8_SB(1, 0), cB + kstep, voffB); PG8_STAGE(PG8_SA(1, 0), cA + kstep, voffA); PG8_STAGE(PG8_SB(1, 1), cB + hstep + kstep, voffB);
        PG8_WAIT_V(6); PG8_BAR;
    } else {
        PG8_STAGE(PG8_SB(0, 0), cB, voffB); PG8_STAGE(PG8_SA(0, 0), cA, voffA); PG8_STAGE(PG8_SB(0, 1), cB + hstep, voffB); PG8_STAGE(PG8_SA(0, 1), cA + hstep, voffA);
        if (wr == 1) PG8_BAR;
        PG8_WAIT_V(4); PG8_BAR;
        PG8_STAGE(PG8_SB(1, 0), cB + kstep, voffB); PG8_STAGE(PG8_SA(1, 0), cA + kstep, voffA); PG8_STAGE(PG8_SB(1, 1), cB + hstep + kstep, voffB);
        PG8_WAIT_V(6); PG8_BAR;
    }
    for (;;) {
        const bool has_next = S.next(ui + 1, nxt);
        const char* nA = has_next ? (const char*)g.A + (size_t)nxt.pm * tstep : cA; const char* nB = has_next ? (const char*)g.Bt + (size_t)nxt.pn * tstep : cB;
        for (int t = 0; t < nt; t += 2) {
            const bool last = (t == nt - 2);
            const char* a1 = cA + (size_t)(t + 1) * kstep;
            const char* a2 = last ? nA : cA + (size_t)(t + 2) * kstep; const char* b2 = last ? nB : cB + (size_t)(t + 2) * kstep;
            const char* a3 = a2 + kstep; const char* b3 = b2 + kstep;
            if (last && has_next) S.a_ready(nxt);
            if constexpr (SP2) {
            PG8_LDB(B0, 0, 0); PG8_LDB(B1, 0, 1); PG8_SCHED; PG8_LDA(At, 0, 0); PG8_STAGE(PG8_SA(1, 1), a1 + hstep, voffA);
            PG8_WAIT_V(8); PG8_WAIT_L(0); PG8_BAR; PG8_MMA(0, 0, At, B0); PG8_MMA(0, 1, At, B1); PG8_BAR; PG8_SCHED;
            PG8_LDA(At, 0, 1); PG8_STAGE(PG8_SB(0, 0), b2, voffB); PG8_STAGE(PG8_SB(0, 1), b2 + hstep, voffB); PG8_STAGE(PG8_SA(0, 0), a2, voffA);
            PG8_WAIT_V(8); PG8_WAIT_L(0); PG8_BAR; PG8_MMA(1, 0, At, B0); PG8_MMA(1, 1, At, B1); PG8_BAR; PG8_SCHED;
            PG8_LDB(B0, 1, 0); PG8_LDB(B1, 1, 1); PG8_SCHED; PG8_LDA(At, 1, 0); PG8_STAGE(PG8_SA(0, 1), a2 + hstep, voffA);
            PG8_WAIT_V(8); PG8_WAIT_L(0); PG8_BAR; PG8_MMA(0, 0, At, B0); PG8_MMA(0, 1, At, B1); PG8_BAR; PG8_SCHED;
            PG8_LDA(At, 1, 1); PG8_STAGE(PG8_SB(1, 0), b3, voffB); PG8_STAGE(PG8_SB(1, 1), b3 + hstep, voffB); PG8_STAGE(PG8_SA(1, 0), a3, voffA);
            PG8_WAIT_V(8); PG8_WAIT_L(0); PG8_BAR; PG8_MMA(1, 0, At, B0); PG8_MMA(1, 1, At, B1); PG8_BAR; PG8_SCHED;
            } else {
            PG8_LDB(B0, 0, 0); PG8_SCHED; PG8_LDA(At, 0, 0); PG8_STAGE(PG8_SA(1, 1), a1 + hstep, voffA);
            PG8_WAIT_L(8); PG8_BAR; PG8_WAIT_L(0); PG8_MMA(0, 0, At, B0); PG8_BAR; PG8_SCHED;
            PG8_LDB(B1, 0, 1); PG8_STAGE(PG8_SB(0, 0), b2, voffB);
            PG8_BAR; PG8_WAIT_L(0); PG8_MMA(0, 1, At, B1); PG8_BAR;
            PG8_LDA(At, 0, 1); PG8_STAGE(PG8_SA(0, 0), a2, voffA);
            PG8_BAR; PG8_WAIT_L(0); PG8_MMA(1, 0, At, B0); PG8_BAR; PG8_SCHED;
            PG8_STAGE(PG8_SB(0, 1), b2 + hstep, voffB);
            PG8_WAIT_V(6); PG8_BAR; PG8_MMA(1, 1, At, B1); PG8_BAR;
            PG8_LDB(B0, 1, 0); PG8_SCHED; PG8_LDA(At, 1, 0); PG8_STAGE(PG8_SA(0, 1), a2 + hstep, voffA);
            PG8_WAIT_L(8); PG8_BAR; PG8_WAIT_L(0); PG8_MMA(0, 0, At, B0); PG8_BAR; PG8_SCHED;
            PG8_LDB(B1, 1, 1); PG8_STAGE(PG8_SB(1, 0), b3, voffB);
            PG8_BAR; PG8_WAIT_L(0); PG8_MMA(0, 1, At, B1); PG8_BAR;
            PG8_LDA(At, 1, 1); PG8_STAGE(PG8_SA(1, 0), a3, voffA);
            PG8_BAR; PG8_WAIT_L(0); PG8_MMA(1, 0, At, B0); PG8_BAR; PG8_SCHED;
            PG8_STAGE(PG8_SB(1, 1), b3 + hstep, voffB);
            PG8_WAIT_V(6); PG8_BAR; PG8_MMA(1, 1, At, B1); PG8_BAR;
            }
        }
        if constexpr (ALIGN_EPI) { if (wr == 0) PG8_BAR; }
        if constexpr (!Epi::AFTER_DRAIN) { E(acc, cur, wr, wc, fr, fq); S.done(cur); }
        if (!has_next) break;
#pragma unroll
        for (int a = 0; a < 2; ++a)
#pragma unroll
            for (int b = 0; b < 2; ++b)
#pragma unroll
                for (int m = 0; m < 4; ++m)
#pragma unroll
                    for (int n = 0; n < 2; ++n) acc[a][b][m][n] = (f32x4){0.f, 0.f, 0.f, 0.f};
        cur = nxt; cA = nA; cB = nB; ++ui;
        if constexpr (ALIGN_EPI) { if (wr == 1) PG8_BAR; }
    }
    PG8_WAIT_V(0);
    if constexpr (!ALIGN_EPI) { if (wr == 0) PG8_BAR; }
    PG8_BAR;
#undef PG8_SA
#undef PG8_SB
#undef PG8_STAGE
#undef PG8_LDA
#undef PG8_LDB
#undef PG8_MMA
#undef PG8_WAIT_V
#undef PG8_WAIT_L
#undef PG8_BAR
#undef PG8_SCHED
}
}

constexpr int NWAVES = 8;
constexpr int N_LAUNCHES = MK_N_LAUNCHES;
constexpr int DEPTH = 2, NB = 4, SEQ = 2048, DM = 2048, M = NB * SEQ, INW = 5120, DFF = 8192;
constexpr int NPHASE = 1 + 7 * DEPTH;
constexpr float NORM_EPS = 1e-6f;
constexpr float LOG2E = 1.4426950408889634f;
constexpr int C_AU = 0, C_AV = 512, C_BQ = 1024, C_BK = 1536, C_BV = 2048, C_CQ = 2560, C_CK = 3072, C_CV = 3584, C_DA = 4096, C_DG = 4608;

constexpr size_t MiB = 1u << 20;
constexpr size_t WS_RINV = 1 * MiB, WS_SSQ = 2 * MiB;
constexpr size_t WS_W = 4 * MiB, W_LAYER = 92 * MiB, W_IN = 0, W_OUT = 20 * MiB, W_FF1 = 28 * MiB, W_FF2 = 60 * MiB;
constexpr size_t WS_XB = 188 * MiB;
constexpr size_t WS_R = 220 * MiB, R_PROJ = 0, R_MIXED = 80 * MiB, R_Y1 = 112 * MiB, R_F = 0, R_Y2 = 128 * MiB;
constexpr size_t WS_END = 412 * MiB;

constexpr int RING_BYTES = 131072;
constexpr int LDS_BYTES = 147456;

#define LAS __attribute__((address_space(3)))
typedef unsigned short bf16;
typedef unsigned v4u __attribute__((ext_vector_type(4)));
typedef float f32x4 __attribute__((ext_vector_type(4)));
#define LDS_WAIT() asm volatile("s_waitcnt lgkmcnt(0)" ::: "memory")

__device__ __forceinline__ unsigned f2bf(float f) { unsigned u = __builtin_bit_cast(unsigned, f); return (u + 0x7fffu + ((u >> 16) & 1u)) >> 16; }
__device__ __forceinline__ unsigned pk2(float lo, float hi) { return f2bf(lo) | (f2bf(hi) << 16); }
__device__ __forceinline__ float bf_lo(unsigned u) { return __uint_as_float(u << 16); }
__device__ __forceinline__ float bf_hi(unsigned u) { return __uint_as_float(u & 0xffff0000u); }
__device__ __forceinline__ float bf1(bf16 h) { return __uint_as_float(((unsigned)h) << 16); }
__device__ __forceinline__ float wave_sum(float v) {
#pragma unroll
    for (int o = 1; o < 64; o <<= 1) v += __shfl_xor(v, o);
    return v;
}
__device__ __forceinline__ float gelu_tanh(float x) { const float z = 0.7978845608028654f * (x + 0.044715f * x * x * x); return x / (1.f + __expf(-2.f * z)); }
__device__ __forceinline__ float sigmoidf_(float x) { return 1.f / (1.f + __expf(-x)); }

struct Args { const float* in[16]; float* out; unsigned char* ws; int ph_lo, ph_hi; };

struct Ctx {
    int tid, lane, wave, G, blk;
    LAS unsigned char* lds;
};

__device__ __forceinline__ void p0_transpose_item(const float* W, int K, int N, bf16* WT, const float* gk, LAS float* scr, int item, int lane) {
    const int nblk = N / 32, kb = item / nblk, nb = item % nblk, k0 = 64 * kb, n0 = 32 * nb;
#pragma unroll 8
    for (int i = 0; i < 32; ++i) { const int kk = 2 * i + (lane >> 5); const float sc = gk ? gk[k0 + kk] : 1.f; scr[kk * 33 + (lane & 31)] = W[(size_t)(k0 + kk) * N + n0 + (lane & 31)] * sc; }
    LDS_WAIT(); asm volatile("" ::: "memory");
    const int c = lane & 7;
#pragma unroll
    for (int j = 0; j < 4; ++j) { const int n = (lane >> 3) + 8 * j; const LAS float* s = scr + (8 * c) * 33 + n;
        v4u o; o.x = pk2(s[0 * 33], s[1 * 33]); o.y = pk2(s[2 * 33], s[3 * 33]); o.z = pk2(s[4 * 33], s[5 * 33]); o.w = pk2(s[6 * 33], s[7 * 33]);
        *(v4u*)(WT + (size_t)(n0 + n) * K + k0 + 8 * c) = o; }
    LDS_WAIT(); asm volatile("" ::: "memory");
}

__device__ __forceinline__ void p0_prologue(const Ctx& C, const Args& a) {
    LAS float* scr = (LAS float*)(C.lds + C.wave * 16384);
    const int gw = C.blk * NWAVES + C.wave, NGW = C.G * NWAVES;
    constexpr int I_IN = (DM / 64) * (INW / 32), I_OUT = (DM / 64) * (DM / 32), I_F1 = (DM / 64) * (DFF / 32), I_F2 = (DFF / 64) * (DM / 32);
    constexpr int PER_LAYER = I_IN + I_OUT + I_F1 + I_F2;
    for (int it = gw; it < DEPTH * PER_LAYER; it += NGW) {
        const int li = it / PER_LAYER; int r = it % PER_LAYER;
        unsigned char* wb = a.ws + WS_W + (size_t)li * W_LAYER;
        if (r < I_IN) { p0_transpose_item(a.in[3] + (size_t)li * DM * INW, DM, INW, (bf16*)(wb + W_IN), a.in[1] + li * DM, scr, r, C.lane); continue; } r -= I_IN;
        if (r < I_OUT) { p0_transpose_item(a.in[11] + (size_t)li * DM * DM, DM, DM, (bf16*)(wb + W_OUT), nullptr, scr, r, C.lane); continue; } r -= I_OUT;
        if (r < I_F1) { p0_transpose_item(a.in[14] + (size_t)li * DM * DFF, DM, DFF, (bf16*)(wb + W_FF1), a.in[12] + li * DM, scr, r, C.lane); continue; } r -= I_F1;
        p0_transpose_item(a.in[15] + (size_t)li * DFF * DM, DFF, DM, (bf16*)(wb + W_FF2), nullptr, scr, r, C.lane);
    }
    const float* x = a.in[0]; bf16* xb = (bf16*)(a.ws + WS_XB); float* rinv = (float*)(a.ws + WS_RINV);
    for (int m = gw; m < M; m += NGW) {
        const f32x4* xr = (const f32x4*)(x + (size_t)m * DM) + C.lane; unsigned long long* o8 = (unsigned long long*)(xb + (size_t)m * DM) + C.lane; float s = 0.f;
#pragma unroll
        for (int j = 0; j < 8; ++j) { const f32x4 v = xr[64 * j]; s += (v.x * v.x + v.y * v.y) + (v.z * v.z + v.w * v.w);
            o8[64 * j] = (unsigned long long)pk2(v.x, v.y) | ((unsigned long long)pk2(v.z, v.w) << 32); }
        s = wave_sum(s);
        if (C.lane == 0) rinv[m] = 1.f / sqrtf(s * (1.f / DM) + NORM_EPS);
    }
}

__device__ __forceinline__ void resid_phase(const Ctx& C, const Args& a, const float* xold, const float* y, const float* g) {
    const int gw = C.blk * NWAVES + C.wave, NGW = C.G * NWAVES;
    const float* ssq = (const float*)(a.ws + WS_SSQ); bf16* xb = (bf16*)(a.ws + WS_XB); float* rinv = (float*)(a.ws + WS_RINV);
    for (int m = gw; m < M; m += NGW) {
        float p = (C.lane < 32) ? ssq[(size_t)m * 32 + C.lane] : 0.f; p = wave_sum(p);
        const float rs = 1.f / sqrtf(p * (1.f / DM) + NORM_EPS);
        const f32x4* xr = (const f32x4*)(xold + (size_t)m * DM) + C.lane; const f32x4* yr = (const f32x4*)(y + (size_t)m * DM) + C.lane; const f32x4* gr = (const f32x4*)g + C.lane;
        f32x4* orow = (f32x4*)(a.out + (size_t)m * DM) + C.lane; unsigned long long* o8 = (unsigned long long*)(xb + (size_t)m * DM) + C.lane; float s = 0.f;
#pragma unroll
        for (int j = 0; j < 8; ++j) { const f32x4 xv = xr[64 * j], yv = yr[64 * j], gv = gr[64 * j]; const f32x4 v = xv + yv * rs * gv;
            s += (v.x * v.x + v.y * v.y) + (v.z * v.z + v.w * v.w); orow[64 * j] = v;
            o8[64 * j] = (unsigned long long)pk2(v.x, v.y) | ((unsigned long long)pk2(v.z, v.w) << 32); }
        s = wave_sum(s);
        if (C.lane == 0) rinv[m] = 1.f / sqrtf(s * (1.f / DM) + NORM_EPS);
    }
}

__device__ __forceinline__ void att_key(const bf16* kp, const bf16* vp, float bias2, const float (&q)[64], float& m, float& l, float (&o)[64]) {
    float s = 0.f;
#pragma unroll
    for (int c = 0; c < 8; ++c) { const uint4 kk = ((const uint4*)kp)[c];
        s += q[8 * c + 0] * bf_lo(kk.x) + q[8 * c + 1] * bf_hi(kk.x) + q[8 * c + 2] * bf_lo(kk.y) + q[8 * c + 3] * bf_hi(kk.y)
           + q[8 * c + 4] * bf_lo(kk.z) + q[8 * c + 5] * bf_hi(kk.z) + q[8 * c + 6] * bf_lo(kk.w) + q[8 * c + 7] * bf_hi(kk.w); }
    s += bias2;
    if (s > m) { const float al = __builtin_amdgcn_exp2f(m - s); l *= al;
#pragma unroll
        for (int d = 0; d < 64; ++d) o[d] *= al;
        m = s; }
    const float p = __builtin_amdgcn_exp2f(s - m);
    l += p;
#pragma unroll
    for (int c = 0; c < 8; ++c) { const uint4 vv = ((const uint4*)vp)[c];
        o[8 * c + 0] += p * bf_lo(vv.x); o[8 * c + 1] += p * bf_hi(vv.x); o[8 * c + 2] += p * bf_lo(vv.y); o[8 * c + 3] += p * bf_hi(vv.y);
        o[8 * c + 4] += p * bf_lo(vv.z); o[8 * c + 5] += p * bf_hi(vv.z); o[8 * c + 6] += p * bf_lo(vv.w); o[8 * c + 7] += p * bf_hi(vv.w); }
}
__device__ __forceinline__ void load_q64(const bf16* qp, float sc, float (&q)[64]) {
#pragma unroll
    for (int c = 0; c < 8; ++c) { const uint4 qq = ((const uint4*)qp)[c];
        q[8 * c + 0] = sc * bf_lo(qq.x); q[8 * c + 1] = sc * bf_hi(qq.x); q[8 * c + 2] = sc * bf_lo(qq.y); q[8 * c + 3] = sc * bf_hi(qq.y);
        q[8 * c + 4] = sc * bf_lo(qq.z); q[8 * c + 5] = sc * bf_hi(qq.z); q[8 * c + 6] = sc * bf_lo(qq.w); q[8 * c + 7] = sc * bf_hi(qq.w); }
}
__device__ __forceinline__ void store64_bf16(bf16* op, const float (&o)[64]) {
#pragma unroll
    for (int c = 0; c < 8; ++c) { v4u w; w.x = pk2(o[8 * c + 0], o[8 * c + 1]); w.y = pk2(o[8 * c + 2], o[8 * c + 3]); w.z = pk2(o[8 * c + 4], o[8 * c + 5]); w.w = pk2(o[8 * c + 6], o[8 * c + 7]);
        ((v4u*)op)[c] = w; }
}

__device__ __forceinline__ void diff_item(const Ctx& C, const Args& a, int li, int b, int h, int qblk, float lam, float lam_init) {
    const bf16* proj = (const bf16*)(a.ws + WS_R + R_PROJ); bf16* mixed = (bf16*)(a.ws + WS_R + R_MIXED);
    const int qi = qblk * 32 + (C.lane & 31), half = C.lane >> 5; const size_t row = (size_t)b * SEQ + qi;
    const float slope2 = exp2f(-8.f * (float)(3 * h + 1) / 12.f) * LOG2E;
    const int jmax = qblk * 32 + 31;
    float q[64], o[64]; float m, l;
    LAS float* o0 = (LAS float*)C.lds + C.tid;
    load_q64(proj + row * INW + C_BQ + h * 128, 0.125f * LOG2E, q);
    m = -INFINITY; l = 0.f;
#pragma unroll
    for (int d = 0; d < 64; ++d) o[d] = 0.f;
    for (int j = 0; j <= jmax; ++j) { const bf16* kr = proj + ((size_t)b * SEQ + j) * INW;
        if (j <= qi) att_key(kr + C_BK + h * 128, kr + C_BV + h * 128 + half * 64, slope2 * (float)(j - qi), q, m, l, o); }
    { const float inv = 1.f / l;
#pragma unroll
      for (int d = 0; d < 64; ++d) o0[d * 512] = o[d] * inv; }
    load_q64(proj + row * INW + C_BQ + h * 128 + 64, 0.125f * LOG2E, q);
    m = -INFINITY; l = 0.f;
#pragma unroll
    for (int d = 0; d < 64; ++d) o[d] = 0.f;
    for (int j = 0; j <= jmax; ++j) { const bf16* kr = proj + ((size_t)b * SEQ + j) * INW;
        if (j <= qi) att_key(kr + C_BK + h * 128 + 64, kr + C_BV + h * 128 + half * 64, slope2 * (float)(j - qi), q, m, l, o); }
    float ss = 0.f;
    { const float inv = lam / l;
#pragma unroll
      for (int d = 0; d < 64; ++d) { o[d] = o0[d * 512] - o[d] * inv; ss += o[d] * o[d]; } }
    ss += __shfl_xor(ss, 32);
    const float r = (1.f - lam_init) / sqrtf(ss * (1.f / 128.f) + NORM_EPS);
    const float* sg = a.in[7] + li * 128 + half * 64;
#pragma unroll
    for (int d = 0; d < 64; ++d) o[d] = o[d] * r * sg[d];
    store64_bf16(mixed + row * DM + 512 + h * 128 + half * 64, o);
}

__device__ __forceinline__ void dil_item(const Ctx& C, const Args& a, int b, int h, int qblk) {
    const bf16* proj = (const bf16*)(a.ws + WS_R + R_PROJ); bf16* mixed = (bf16*)(a.ws + WS_R + R_MIXED);
    const int t = qblk * 64 + C.lane; const size_t row = (size_t)b * SEQ + t;
    const int sidx = 3 * (h >> 1) + 1 + (h & 1);
    const float slope2 = exp2f(-8.f * (float)(sidx + 1) / 12.f) * LOG2E;
    float q[64], o[64]; float m = -INFINITY, l = 0.f;
    load_q64(proj + row * INW + C_CQ + h * 64, 0.125f * LOG2E, q);
#pragma unroll
    for (int d = 0; d < 64; ++d) o[d] = 0.f;
    for (int pat = 0; pat < 3; ++pat) { const int dil = 1 << (2 * pat);
        for (int step = 0; step <= 128; ++step) { const int kpos = t - dil * step;
            if (kpos >= 0) { const bf16* kr = proj + ((size_t)b * SEQ + kpos) * INW; att_key(kr + C_CK + h * 64, kr + C_CV + h * 64, -slope2 * (float)(step * dil), q, m, l, o); } } }
    const float inv = 1.f / l;
#pragma unroll
    for (int d = 0; d < 64; ++d) o[d] *= inv;
    store64_bf16(mixed + row * DM + 1024 + h * 64, o);
}

__device__ __forceinline__ void gmlp_unit(const Ctx& C, const Args& a, int li, int unit) {
    const bf16* proj = (const bf16*)(a.ws + WS_R + R_PROJ); bf16* mixed = (bf16*)(a.ws + WS_R + R_MIXED);
    const size_t row0 = (size_t)unit * 128;
    LAS bf16* vn = (LAS bf16*)C.lds;
    for (int tt = 0; tt < 16; ++tt) { const int t = C.wave * 16 + tt;
        const uint4 vv = *(const uint4*)(proj + (row0 + t) * INW + C_AV + C.lane * 8);
        float v[8] = {bf_lo(vv.x), bf_hi(vv.x), bf_lo(vv.y), bf_hi(vv.y), bf_lo(vv.z), bf_hi(vv.z), bf_lo(vv.w), bf_hi(vv.w)}; float s = 0.f;
#pragma unroll
        for (int e = 0; e < 8; ++e) { v[e] = gelu_tanh(v[e]); s += v[e]; }
        const float mean = wave_sum(s) * (1.f / 512.f); float s2 = 0.f;
#pragma unroll
        for (int e = 0; e < 8; ++e) { v[e] -= mean; s2 += v[e] * v[e]; }
        const float rstd = 1.f / sqrtf(wave_sum(s2) * (1.f / 512.f) + NORM_EPS);
        v4u w; w.x = pk2(v[0] * rstd, v[1] * rstd); w.y = pk2(v[2] * rstd, v[3] * rstd); w.z = pk2(v[4] * rstd, v[5] * rstd); w.w = pk2(v[6] * rstd, v[7] * rstd);
        *(LAS v4u*)(vn + t * 512 + C.lane * 8) = w; }
    __syncthreads();
    const int ch = C.tid, g = C.wave;
    const float* W = a.in[4] + ((size_t)li * 8 + g) * 128 * 128; const float* bs = a.in[5] + ((size_t)li * 8 + g) * 128;
    for (int tb = 0; tb < 4; ++tb) {
        float acc[32];
#pragma unroll
        for (int i = 0; i < 32; ++i) acc[i] = 0.f;
        const int send = tb * 32 + 31;
        for (int s = 0; s <= send; ++s) { const float xv = bf1(vn[s * 512 + ch]);
#pragma unroll
            for (int i = 0; i < 32; ++i) { const int t = tb * 32 + i; const float wv = (t >= s) ? W[t * 128 + s] : 0.f; acc[i] += wv * xv; } }
#pragma unroll
        for (int i = 0; i < 32; ++i) { const int t = tb * 32 + i; const float z = acc[i] + bs[t];
            const float u = gelu_tanh(bf1(proj[(row0 + t) * INW + C_AU + ch]));
            mixed[(row0 + t) * DM + ch] = (bf16)f2bf(u * z); }
    }
    __syncthreads();
}

__device__ __forceinline__ void conv_unit(const Ctx& C, const Args& a, int li, int unit) {
    const bf16* proj = (const bf16*)(a.ws + WS_R + R_PROJ); bf16* mixed = (bf16*)(a.ws + WS_R + R_MIXED);
    const int b = unit >> 6, t0 = (unit & 63) * 32, c = C.tid;
    LAS float* hs = (LAS float*)C.lds;
    const float* cw = a.in[8] + (size_t)li * 31 * 512;
#pragma unroll 2
    for (int i = 0; i < 62; ++i) { const int s = t0 - 30 + i; float hv = 0.f;
        if (s >= 0) { const bf16* pr = proj + ((size_t)b * SEQ + s) * INW; hv = bf1(pr[C_DA + c]) * sigmoidf_(bf1(pr[C_DG + c])); }
        hs[i * 512 + c] = hv; }
    float w[31];
#pragma unroll
    for (int k = 0; k < 31; ++k) w[k] = cw[k * 512 + c];
    const float bd = a.in[9][li * 512 + c];
#pragma unroll 1
    for (int j = 0; j < 32; ++j) { float acc = bd;
#pragma unroll
        for (int k = 0; k < 31; ++k) acc += w[k] * hs[(j + k) * 512 + c];
        hs[j * 512 + c] = acc; }
    __syncthreads();
    const float* ng = a.in[10] + li * 512 + C.lane * 8;
#pragma unroll 1
    for (int jj = 0; jj < 4; ++jj) { const int j = C.wave * 4 + jj; float v[8]; float ss = 0.f;
#pragma unroll
        for (int e = 0; e < 8; ++e) { v[e] = hs[j * 512 + C.lane * 8 + e]; ss += v[e] * v[e]; }
        const float r = 1.f / sqrtf(wave_sum(ss) * (1.f / 512.f) + NORM_EPS);
#pragma unroll
        for (int e = 0; e < 8; ++e) { const float hn = v[e] * r * ng[e]; v[e] = hn * sigmoidf_(hn); }
        v4u wv; wv.x = pk2(v[0], v[1]); wv.y = pk2(v[2], v[3]); wv.z = pk2(v[4], v[5]); wv.w = pk2(v[6], v[7]);
        *(v4u*)(mixed + ((size_t)b * SEQ + t0 + j) * DM + 1536 + C.lane * 8) = wv; }
    __syncthreads();
}

__device__ __forceinline__ void mixer_phase(const Ctx& C, const Args& a, int li) {
    const float* lp = a.in[6] + li * 256;
    const float d01 = wave_sum(lp[C.lane] * lp[64 + C.lane]), d23 = wave_sum(lp[128 + C.lane] * lp[192 + C.lane]);
    const float lam_init = 0.8f - 0.6f * expf(-0.3f * (float)li);
    const float lam = expf(d01) - expf(d23) + lam_init;
    for (int u = C.blk; u < 256; u += C.G) if ((u & 3) == 0) gmlp_unit(C, a, li, u >> 2);
    for (int u = C.blk; u < 256; u += C.G) conv_unit(C, a, li, u);
    for (int bb = C.blk; bb < 256; bb += C.G) {
        const int w = C.wave, type = (w ^ (w >> 2)) & 1, r = w >> 1, aa = bb >> 2, cc = bb & 3;
        if (type == 0) {
            const int bh = cc * 4 + r; int qb = (r & 2) ? ((aa + 32) & 63) : aa; if (r & 1) qb = 63 - qb;
            diff_item(C, a, li, bh >> 2, bh & 3, qb, lam, lam_init);
        } else {
            const int it = bb * 4 + r; dil_item(C, a, it >> 8, (it >> 5) & 7, it & 31);
        }
    }
}

__global__ void __launch_bounds__(NWAVES * 64, 2) mk_fwd(Args args) {
    extern __shared__ __attribute__((aligned(16))) unsigned char lds[];
    Ctx C; C.tid = threadIdx.x; C.lane = C.tid & 63; C.wave = __builtin_amdgcn_readfirstlane(C.tid >> 6); C.G = gridDim.x; C.blk = blockIdx.x; C.lds = (LAS unsigned char*)lds;
    const int lo = args.ph_lo, hi = args.ph_hi;
    unsigned char* ws = args.ws;
    float* rinv = (float*)(ws + WS_RINV); float* ssq = (float*)(ws + WS_SSQ);
    bf16* xb = (bf16*)(ws + WS_XB); bf16* proj = (bf16*)(ws + WS_R + R_PROJ); bf16* mixed = (bf16*)(ws + WS_R + R_MIXED);
    float* y1 = (float*)(ws + WS_R + R_Y1); float* y2 = (float*)(ws + WS_R + R_Y2); bf16* fb = (bf16*)(ws + WS_R + R_F);
#define IN(k) (lo <= (k) && (k) < hi)
#define SEAM(k) do { if (IN(k) && IN((k) + 1)) { cg::this_grid().sync(); } } while (0)
    if (IN(0)) { p0_prologue(C, args); }
    SEAM(0);
    for (int li = 0; li < DEPTH; ++li) {
        const int p = 1 + 7 * li;
        unsigned char* wb = ws + WS_W + (size_t)li * W_LAYER;
        asm volatile("" : "+s"(wb), "+s"(xb), "+s"(proj), "+s"(mixed), "+s"(y1), "+s"(y2), "+s"(fb), "+s"(rinv), "+s"(ssq));
        Ctx Cl; { int t_ = threadIdx.x, b_ = blockIdx.x, g_ = gridDim.x; asm volatile("" : "+v"(t_), "+s"(b_), "+s"(g_));
            Cl.tid = t_; Cl.lane = t_ & 63; Cl.wave = __builtin_amdgcn_readfirstlane(t_ >> 6); Cl.G = g_; Cl.blk = b_; Cl.lds = (LAS unsigned char*)lds; }
        if (IN(p + 0)) {
            pg8::Gemm g{xb, (const bf16*)(wb + W_IN), M, INW, DM}; pg8::StaticOrder S; S.init(M, INW, Cl.G, Cl.blk);
            pg8::EpiRowScaleBf16 E{proj, INW, rinv, 0};
            pg8::gemm_phase<pg8::EpiRowScaleBf16, pg8::StaticOrder, true, true>(Cl.lds, g, S, E, Cl.tid);
        }
        SEAM(p + 0);
        if (IN(p + 1)) { mixer_phase(Cl, args, li); }
        SEAM(p + 1);
        if (IN(p + 2)) {
            pg8::Gemm g{mixed, (const bf16*)(wb + W_OUT), M, DM, DM}; pg8::StaticOrder S; S.init(M, DM, Cl.G, Cl.blk);
            pg8::EpiF32Ssq E{y1, DM, ssq};
            pg8::gemm_phase<pg8::EpiF32Ssq, pg8::StaticOrder, true, true>(Cl.lds, g, S, E, Cl.tid);
        }
        SEAM(p + 2);
        if (IN(p + 3)) { resid_phase(Cl, args, li == 0 ? args.in[0] : args.out, y1, args.in[2] + li * DM); }
        SEAM(p + 3);
        if (IN(p + 4)) {
            pg8::Gemm g{xb, (const bf16*)(wb + W_FF1), M, DFF, DM}; pg8::StaticOrder S; S.init(M, DFF, Cl.G, Cl.blk);
            pg8::EpiRowScaleBf16 E{fb, DFF, rinv, 1};
            pg8::gemm_phase<pg8::EpiRowScaleBf16, pg8::StaticOrder, true, true>(Cl.lds, g, S, E, Cl.tid);
        }
        SEAM(p + 4);
        if (IN(p + 5)) {
            pg8::Gemm g{fb, (const bf16*)(wb + W_FF2), M, DM, DFF}; pg8::StaticOrder S; S.init(M, DM, Cl.G, Cl.blk);
            pg8::EpiF32Ssq E{y2, DM, ssq};
            pg8::gemm_phase<pg8::EpiF32Ssq, pg8::StaticOrder, true, true>(Cl.lds, g, S, E, Cl.tid);
        }
        SEAM(p + 5);
        if (IN(p + 6)) { resid_phase(Cl, args, args.out, y2, args.in[13] + li * DM); }
        SEAM(p + 6);
    }
#undef IN
#undef SEAM
}

extern "C" void kernel_launch(void* const* d_in, const int* in_sizes, int n_in, void* d_out, int out_size, void* d_ws, size_t ws_size, hipStream_t stream) {
    static int grid = 0;
    if (grid == 0) {
        if (n_in != 16 || in_sizes[0] != M * DM || out_size != M * DM || ws_size < WS_END) { fprintf(stderr, "kernel_launch: unexpected shapes (n_in %d, in0 %d, out %d, ws %zu); nothing launched\n", n_in, n_in > 0 ? in_sizes[0] : -1, out_size, ws_size); grid = -1; return; }
        int dev = 0, cus = 0, per_cu = 0;
        if (hipGetDevice(&dev) != hipSuccess || hipDeviceGetAttribute(&cus, hipDeviceAttributeMultiprocessorCount, dev) != hipSuccess) { grid = -1; return; }
        if (hipFuncSetAttribute((const void*)mk_fwd, hipFuncAttributeMaxDynamicSharedMemorySize, LDS_BYTES) != hipSuccess) { fprintf(stderr, "kernel_launch: hipFuncSetAttribute failed\n"); grid = -1; return; }
        if (hipOccupancyMaxActiveBlocksPerMultiprocessor(&per_cu, (const void*)mk_fwd, NWAVES * 64, LDS_BYTES) != hipSuccess || per_cu < 1) { fprintf(stderr, "kernel_launch: occupancy query says %d\n", per_cu); per_cu = 1; }
        (void)hipGetLastError();
        grid = cus;
    }
    if (grid < 0) return;
    Args a{};
    for (int i = 0; i < 16; ++i) a.in[i] = (const float*)d_in[i];
    a.out = (float*)d_out; a.ws = (unsigned char*)d_ws;
    if (N_LAUNCHES == 1) {
        a.ph_lo = 0; a.ph_hi = NPHASE;
        void* kargs[] = {&a};
        hipError_t e = hipLaunchCooperativeKernel((const void*)mk_fwd, dim3(grid), dim3(NWAVES * 64), kargs, LDS_BYTES, stream);
        if (e != hipSuccess) fprintf(stderr, "kernel_launch: cooperative launch failed: %s (grid %d)\n", hipGetErrorString(e), grid);
    } else {
        for (int k = 0; k < NPHASE; ++k) {
            a.ph_lo = k; a.ph_hi = k + 1;
            hipLaunchKernelGGL(mk_fwd, dim3(grid), dim3(NWAVES * 64), LDS_BYTES, stream, a);
        }
    }
}
```

```cpp
#include <hip/hip_runtime.h>
#include <hip/hip_cooperative_groups.h>
#include <cstdio>
#include <cstdint>
namespace cg = cooperative_groups;

#ifndef MK_N_LAUNCHES
#define MK_N_LAUNCHES 1
#endif

namespace pg8 {
#define PG8_LAS __attribute__((address_space(3)))
typedef unsigned short bf16_t;
typedef short bf16x8 __attribute__((ext_vector_type(8)));
typedef float f32x4 __attribute__((ext_vector_type(4)));
typedef unsigned u32x4 __attribute__((ext_vector_type(4)));
constexpr int BM = 256, BK = 64, HALF = 128, HTB = HALF * BK * 2  , STAGE_BYTES = 8 * HTB, NXCD = 8, WGM = 8;

__host__ __device__ __forceinline__ int lds_byte(int r, int c) { const int st = (r >> 4) * 2 + (c >> 5), rr = r & 15, cc = c & 31, ob = rr * 64 + cc * 2; return st * 1024 + (ob ^ (((ob >> 9) & 1) << 5)); }
__host__ __device__ __forceinline__ void stage_rc(int b, int& R, int& C) { const int st = b / 1024, sb = b % 1024, swz = sb ^ (((sb >> 9) & 1) << 5); R = (st >> 1) * 16 + swz / 64; C = (st & 1) * 32 + (swz % 64) / 2; }
__host__ __device__ __forceinline__ int perm32(int rho) { const int n = rho >> 4, i = rho & 15; return 8 * (i >> 2) + 4 * n + (i & 3); }

struct Unit { int pm, pn; };
struct Gemm { const bf16_t* A; const bf16_t* Bt; int M, N, K; };

struct StaticOrder {
    int nM, nN, nwg, G, c;
    __host__ __device__ void init(int M, int N, int G_, int c_) { nM = M / BM; nN = N / BM; nwg = nM * nN; G = G_; c = c_; }
    __host__ __device__ bool next(int i, Unit& u) const {
        const long L = (long)i * G + c; if (L >= nwg) return false;
        int wgid = (int)L; { const int q = nwg / NXCD, r = nwg % NXCD, xcd = wgid % NXCD, off = wgid / NXCD; wgid = (xcd < r ? xcd * (q + 1) : r * (q + 1) + (xcd - r) * q) + off; }
        const int nig = WGM * nN, gid = wgid / nig, fm = gid * WGM, gsz = (nM - fm) < WGM ? (nM - fm) : WGM;
        u.pm = fm + ((wgid % nig) % gsz); u.pn = (wgid % nig) / gsz; return true;
    }
    __device__ __forceinline__ void a_ready(const Unit&) const {}
    __device__ __forceinline__ void done(const Unit&) const {}
};

__device__ __forceinline__ unsigned cvt_pk_bf16(float lo, float hi) { unsigned r; asm volatile("v_cvt_pk_bf16_f32 %0, %1, %2" : "=v"(r) : "v"(lo), "v"(hi)); return r; }

struct EpiRowScaleBf16 {
    static constexpr bool PERM = true, AFTER_DRAIN = false;
    bf16_t* O; int ldc; const float* rinv; int act;
    __device__ __forceinline__ void operator()(const f32x4 (&acc)[2][2][4][2], const Unit& u, int wr, int wc, int fr, int fq) const {
        const int row0 = u.pm * BM + wr * 64 + fr; const int col0 = u.pn * BM + wc * 32 + 8 * fq;
#pragma unroll
        for (int ai = 0; ai < 2; ++ai)
#pragma unroll
            for (int m = 0; m < 4; ++m) { const int row = row0 + ai * HALF + m * 16; const float s = rinv[row]; bf16_t* rowp = O + (size_t)row * ldc + col0;
#pragma unroll
                for (int bj = 0; bj < 2; ++bj) { f32x4 v0 = acc[ai][bj][m][0] * s, v1 = acc[ai][bj][m][1] * s;
                    if (act) {
#pragma unroll
                        for (int e = 0; e < 4; ++e) { const float a = fmaxf(v0[e], 0.f), b = fmaxf(v1[e], 0.f); v0[e] = a * a; v1[e] = b * b; } }
                    u32x4 w; w.x = cvt_pk_bf16(v0[0], v0[1]); w.y = cvt_pk_bf16(v0[2], v0[3]); w.z = cvt_pk_bf16(v1[0], v1[1]); w.w = cvt_pk_bf16(v1[2], v1[3]);
                    *(u32x4*)(rowp + bj * HALF) = w; } }
    }
};
struct EpiF32Ssq {
    static constexpr bool PERM = false, AFTER_DRAIN = false;
    float* Y; int ldc; float* ssq;
    __device__ __forceinline__ void operator()(const f32x4 (&acc)[2][2][4][2], const Unit& u, int wr, int wc, int fr, int fq) const {
        const int row0 = u.pm * BM + wr * 64 + fr; const int col0 = u.pn * BM + wc * 32 + 4 * fq;
#pragma unroll
        for (int ai = 0; ai < 2; ++ai)
#pragma unroll
            for (int m = 0; m < 4; ++m) { const int row = row0 + ai * HALF + m * 16; float* rowp = Y + (size_t)row * ldc + col0; float s = 0.f;
#pragma unroll
                for (int bj = 0; bj < 2; ++bj)
#pragma unroll
                    for (int n = 0; n < 2; ++n) { const f32x4 v = acc[ai][bj][m][n]; s += (v[0] * v[0] + v[1] * v[1]) + (v[2] * v[2] + v[3] * v[3]); *(f32x4*)(rowp + bj * HALF + n * 16) = v; }
                s += __shfl_xor(s, 16); s += __shfl_xor(s, 32);
                if (fq == 0) ssq[(size_t)row * 32 + u.pn * 4 + wc] = s; }
    }
};

template <class Epi, class Sched, bool ALIGN_EPI = false, bool SP2 = false>
__device__ __forceinline__ void gemm_phase(PG8_LAS unsigned char* lds, const Gemm g, const Sched& S, const Epi& E, const int tid) {
    const int wid = __builtin_amdgcn_readfirstlane(tid >> 6), lane = tid & 63, wr = wid >> 2, wc = wid & 3, fr = lane & 15, fq = lane >> 4;
    const int K = g.K, nt = K / BK;
    unsigned voffA[2], voffB[2];
#pragma unroll
    for (int i = 0; i < 2; ++i) { int R, C; stage_rc(tid * 16 + i * 8192, R, C); const int Rb = Epi::PERM ? ((R & ~31) + perm32(R & 31)) : R;
        voffA[i] = (unsigned)(R * K + C) * 2u; voffB[i] = (unsigned)(Rb * K + C) * 2u; }
    const size_t kstep = (size_t)(BK * 2);
    const size_t hstep = (size_t)HALF * K * 2;
    const size_t tstep = 2 * hstep;
    const unsigned ldsw = (unsigned)wid * 1024u;
    const int aoff = lds_byte(wr * 64 + fr, fq * 8), boff = lds_byte(wc * 32 + fr, fq * 8);
#define PG8_SA(b, h) (((b) * 2 + (h)) * HTB)
#define PG8_SB(b, h) ((4 + (b) * 2 + (h)) * HTB)
#define PG8_STAGE(bufoff, gbase, voff) do { _Pragma("unroll") for (int _i = 0; _i < 2; ++_i) \
        __builtin_amdgcn_global_load_lds((const unsigned*)((const char*)(gbase) + (voff)[_i]), (PG8_LAS unsigned*)(lds + (bufoff) + ldsw + _i * 8192), 16, 0, 0); } while (0)
#define PG8_LDA(dst, b, h) do { _Pragma("unroll") for (int m = 0; m < 4; ++m) _Pragma("unroll") for (int k = 0; k < 2; ++k) dst[m][k] = *(const PG8_LAS bf16x8*)(lds + PG8_SA(b, h) + aoff + m * 2048 + k * 1024); } while (0)
#define PG8_LDB(dst, b, h) do { _Pragma("unroll") for (int n = 0; n < 2; ++n) _Pragma("unroll") for (int k = 0; k < 2; ++k) dst[n][k] = *(const PG8_LAS bf16x8*)(lds + PG8_SB(b, h) + boff + n * 2048 + k * 1024); } while (0)
#define PG8_MMA(ai, bj, At, Bt) do { __builtin_amdgcn_s_setprio(1); _Pragma("unroll") for (int m = 0; m < 4; ++m) _Pragma("unroll") for (int n = 0; n < 2; ++n) _Pragma("unroll") for (int k = 0; k < 2; ++k) \
        acc[ai][bj][m][n] = __builtin_amdgcn_mfma_f32_16x16x32_bf16(Bt[n][k], At[m][k], acc[ai][bj][m][n], 0, 0, 0); __builtin_amdgcn_s_setprio(0); } while (0)
#define PG8_WAIT_V(n) asm volatile("s_waitcnt vmcnt(" #n ")" ::: "memory")
#define PG8_WAIT_L(n) asm volatile("s_waitcnt lgkmcnt(" #n ")" ::: "memory")
#define PG8_BAR __builtin_amdgcn_s_barrier()
#define PG8_SCHED __builtin_amdgcn_sched_barrier(0)
    Unit cur, nxt; int ui = 0;
    if (!S.next(0, cur)) return;
    f32x4 acc[2][2][4][2];
#pragma unroll
    for (int a = 0; a < 2; ++a)
#pragma unroll
        for (int b = 0; b < 2; ++b)
#pragma unroll
            for (int m = 0; m < 4; ++m)
#pragma unroll
                for (int n = 0; n < 2; ++n) acc[a][b][m][n] = (f32x4){0.f, 0.f, 0.f, 0.f};
    bf16x8 At[4][2], B0[2][2], B1[2][2];
    const char* cA = (const char*)g.A + (size_t)cur.pm * tstep; const char* cB = (const char*)g.Bt + (size_t)cur.pn * tstep;
    S.a_ready(cur);
    if constexpr (SP2) {
        PG8_STAGE(PG8_SB(0, 0), cB, voffB); PG8_STAGE(PG8_SB(0, 1), cB + hstep, voffB); PG8_STAGE(PG8_SA(0, 0), cA, voffA); PG8_STAGE(PG8_SA(0, 1), cA + hstep, voffA);
        if (wr == 1) PG8_BAR;
        PG8_WAIT_V(2); PG8_BAR;
        PG8_STAGE(PG8_SB(1, 0), cB + kstep, voffB); PG8_STAGE(PG8_SA(1, 0), cA + kstep, voffA); PG8_STAGE(PG8_SB(1, 1), cB + hstep + kstep, voffB);
        PG8_WAIT_V(6); PG8_BAR;
    } else {
        PG8_STAGE(PG8_SB(0, 0), cB, voffB); PG8_STAGE(PG8_SA(0, 0), cA, voffA); PG8_STAGE(PG8_SB(0, 1), cB + hstep, voffB); PG8_STAGE(PG8_SA(0, 1), cA + hstep, voffA);
        if (wr == 1) PG8_BAR;
        PG8_WAIT_V(4); PG8_BAR;
        PG8_STAGE(PG8_SB(1, 0), cB + kstep, voffB); PG8_STAGE(PG8_SA(1, 0), cA + kstep, voffA); PG8_STAGE(PG8_SB(1, 1), cB + hstep + kstep, voffB);
        PG8_WAIT_V(6); PG8_BAR;
    }
    for (;;) {
        const bool has_next = S.next(ui + 1, nxt);
        const char* nA = has_next ? (const char*)g.A + (size_t)nxt.pm * tstep : cA; const char* nB = has_next ? (const char*)g.Bt + (size_t)nxt.pn * tstep : cB;
        for (int t = 0; t < nt; t += 2) {
            const bool last = (t == nt - 2);
            const char* a1 = cA + (size_t)(t + 1) * kstep;
            const char* a2 = last ? nA : cA + (size_t)(t + 2) * kstep; const char* b2 = last ? nB : cB + (size_t)(t + 2) * kstep;
            const char* a3 = a2 + kstep; const char* b3 = b2 + kstep;
            if (last && has_next) S.a_ready(nxt);
            if constexpr (SP2) {
            PG8_LDB(B0, 0, 0); PG8_LDB(B1, 0, 1); PG8_SCHED; PG8_LDA(At, 0, 0); PG8_STAGE(PG8_SA(1, 1), a1 + hstep, voffA);
            PG8_WAIT_V(8); PG8_WAIT_L(0); PG8_BAR; PG8_MMA(0, 0, At, B0); PG8_MMA(0, 1, At, B1); PG8_BAR; PG8_SCHED;
            PG8_LDA(At, 0, 1); PG8_STAGE(PG8_SB(0, 0), b2, voffB); PG8_STAGE(PG8_SB(0, 1), b2 + hstep, voffB); PG8_STAGE(PG8_SA(0, 0), a2, voffA);
            PG8_WAIT_V(8); PG8_WAIT_L(0); PG8_BAR; PG8_MMA(1, 0, At, B0); PG8_MMA(1, 1, At, B1); PG8_BAR; PG8_SCHED;
            PG8_LDB(B0, 1, 0); PG8_LDB(B1, 1, 1); PG8_SCHED; PG8_LDA(At, 1, 0); PG8_STAGE(PG8_SA(0, 1), a2 + hstep, voffA);
            PG8_WAIT_V(8); PG8_WAIT_L(0); PG8_BAR; PG8_MMA(0, 0, At, B0); PG8_MMA(0, 1, At, B1); PG8_BAR; PG8_SCHED;
            PG8_LDA(At, 1, 1); PG8_STAGE(PG8_SB(1, 0), b3, voffB); PG8_STAGE(PG8_SB(1, 1), b3 + hstep, voffB); PG8_STAGE(PG8_SA(1, 0), a3, voffA);
            PG8_WAIT_V(8); PG8_WAIT_L(0); PG8_BAR; PG8_MMA(1, 0, At, B0); PG8_MMA(1, 1, At, B1); PG8_BAR; PG8_SCHED;
            } else {
            PG8_LDB(B0, 0, 0); PG8_SCHED; PG8_LDA(At, 0, 0); PG8_STAGE(PG8_SA(1, 1), a1 + hstep, voffA);
            PG8_WAIT_L(8); PG8_BAR; PG8_WAIT_L(0); PG8_MMA(0, 0, At, B0); PG8_BAR; PG8_SCHED;
            PG8_LDB(B1, 0, 1); PG8_STAGE(PG8_SB(0, 0), b2, voffB);
            PG8_BAR; PG8_WAIT_L(0); PG8_MMA(0, 1, At, B1); PG8_BAR;
            PG8_LDA(At, 0, 1); PG8_STAGE(PG8_SA(0, 0), a2, voffA);
            PG8_BAR; PG8_WAIT_L(0); PG8_MMA(1, 0, At, B0); PG8_BAR; PG8_SCHED;
            PG8_STAGE(PG8_SB(0, 1), b2 + hstep, voffB);
            PG8_WAIT_V(6); PG8_BAR; PG8_MMA(1, 1, At, B1); PG8_BAR;
            PG8_LDB(B0, 1, 0); PG8_SCHED; PG8_LDA(At, 1, 0); PG8_STAGE(PG8_SA(0, 1), a2 + hstep, voffA);
            PG8_WAIT_L(8); PG8_BAR; PG8_WAIT_L(0); PG8_MMA(0, 0, At, B0); PG8_BAR; PG8_SCHED;
            PG8_LDB(B1, 1, 1); PG8_STAGE(PG8_SB(1, 0), b3, voffB);
            PG8_BAR; PG8_WAIT_L(0); PG8_MMA(0, 1, At, B1); PG8_BAR;
            PG8_LDA(At, 1, 1); PG8_STAGE(PG8_SA(1, 0), a3, voffA);
            PG8_BAR; PG8_WAIT_L(0); PG8_MMA(1, 0, At, B0); PG8_BAR; PG8_SCHED;
            PG8_STAGE(PG8_SB(1, 1), b3 + hstep, voffB);
            PG8_WAIT_V(6); PG8_BAR; PG8_MMA(1, 1, At, B1); PG8_BAR;
            }
        }
        if constexpr (ALIGN_EPI) { if (wr == 0) PG8_BAR; }
        if constexpr (!Epi::AFTER_DRAIN) { E(acc, cur, wr, wc, fr, fq); S.done(cur); }
        if (!has_next) break;
#pragma unroll
        for (int a = 0; a < 2; ++a)
#pragma unroll
            for (int b = 0; b < 2; ++b)
#pragma unroll
                for (int m = 0; m < 4; ++m)
#pragma unroll
                    for (int n = 0; n < 2; ++n) acc[a][b][m][n] = (f32x4){0.f, 0.f, 0.f, 0.f};
        cur = nxt; cA = nA; cB = nB; ++ui;
        if constexpr (ALIGN_EPI) { if (wr == 1) PG8_BAR; }
    }
    PG8_WAIT_V(0);
    if constexpr (!ALIGN_EPI) { if (wr == 0) PG8_BAR; }
    PG8_BAR;
#undef PG8_SA
#undef PG8_SB
#undef PG8_STAGE
#undef PG8_LDA
#undef PG8_LDB
#undef PG8_MMA
#undef PG8_WAIT_V
#undef PG8_WAIT_L
#undef PG8_BAR
#undef PG8_SCHED
}
}

constexpr int NWAVES = 8;
constexpr int N_LAUNCHES = MK_N_LAUNCHES;
constexpr int DEPTH = 2, NB = 4, SEQ = 2048, DM = 2048, M = NB * SEQ, INW = 5120, DFF = 8192;
constexpr int NPHASE = 1 + 7 * DEPTH;
constexpr float NORM_EPS = 1e-6f;
constexpr float LOG2E = 1.4426950408889634f;
constexpr int C_AU = 0, C_AV = 512, C_BQ = 1024, C_BK = 1536, C_BV = 2048, C_CQ = 2560, C_CK = 3072, C_CV = 3584, C_DA = 4096, C_DG = 4608;

constexpr size_t MiB = 1u << 20;
constexpr size_t WS_RINV = 1 * MiB, WS_SSQ = 2 * MiB;
constexpr size_t WS_W = 4 * MiB, W_LAYER = 92 * MiB, W_IN = 0, W_OUT = 20 * MiB, W_FF1 = 28 * MiB, W_FF2 = 60 * MiB;
constexpr size_t WS_XB = 188 * MiB;
constexpr size_t WS_R = 220 * MiB, R_PROJ = 0, R_MIXED = 80 * MiB, R_Y1 = 112 * MiB, R_F = 0, R_Y2 = 128 * MiB;
constexpr size_t WS_END = 412 * MiB;

constexpr int RING_BYTES = 131072;
constexpr int LDS_BYTES = 147456;

#define LAS __attribute__((address_space(3)))
typedef unsigned short bf16;
typedef unsigned v4u __attribute__((ext_vector_type(4)));
typedef float f32x4 __attribute__((ext_vector_type(4)));
#define LDS_WAIT() asm volatile("s_waitcnt lgkmcnt(0)" ::: "memory")

__device__ __forceinline__ unsigned f2bf(float f) { unsigned u = __builtin_bit_cast(unsigned, f); return (u + 0x7fffu + ((u >> 16) & 1u)) >> 16; }
__device__ __forceinline__ unsigned pk2(float lo, float hi) { return f2bf(lo) | (f2bf(hi) << 16); }
__device__ __forceinline__ float bf_lo(unsigned u) { return __uint_as_float(u << 16); }
__device__ __forceinline__ float bf_hi(unsigned u) { return __uint_as_float(u & 0xffff0000u); }
__device__ __forceinline__ float bf1(bf16 h) { return __uint_as_float(((unsigned)h) << 16); }
__device__ __forceinline__ float wave_sum(float v) {
#pragma unroll
    for (int o = 1; o < 64; o <<= 1) v += __shfl_xor(v, o);
    return v;
}
__device__ __forceinline__ float gelu_tanh(float x) { const float z = 0.7978845608028654f * (x + 0.044715f * x * x * x); return x / (1.f + __expf(-2.f * z)); }
__device__ __forceinline__ float sigmoidf_(float x) { return 1.f / (1.f + __expf(-x)); }

struct Args { const float* in[16]; float* out; unsigned char* ws; int ph_lo, ph_hi; };

struct Ctx {
    int tid, lane, wave, G, blk;
    LAS unsigned char* lds;
};

__device__ __forceinline__ void p0_transpose_item(const float* W, int K, int N, bf16* WT, const float* gk, LAS float* scr, int item, int lane) {
    const int nblk = N / 32, kb = item / nblk, nb = item % nblk, k0 = 64 * kb, n0 = 32 * nb;
#pragma unroll 8
    for (int i = 0; i < 32; ++i) { const int kk = 2 * i + (lane >> 5); const float sc = gk ? gk[k0 + kk] : 1.f; scr[kk * 33 + (lane & 31)] = W[(size_t)(k0 + kk) * N + n0 + (lane & 31)] * sc; }
    LDS_WAIT(); asm volatile("" ::: "memory");
    const int c = lane & 7;
#pragma unroll
    for (int j = 0; j < 4; ++j) { const int n = (lane >> 3) + 8 * j; const LAS float* s = scr + (8 * c) * 33 + n;
        v4u o; o.x = pk2(s[0 * 33], s[1 * 33]); o.y = pk2(s[2 * 33], s[3 * 33]); o.z = pk2(s[4 * 33], s[5 * 33]); o.w = pk2(s[6 * 33], s[7 * 33]);
        *(v4u*)(WT + (size_t)(n0 + n) * K + k0 + 8 * c) = o; }
    LDS_WAIT(); asm volatile("" ::: "memory");
}

__device__ __forceinline__ void p0_prologue(const Ctx& C, const Args& a) {
    LAS float* scr = (LAS float*)(C.lds + C.wave * 16384);
    const int gw = C.blk * NWAVES + C.wave, NGW = C.G * NWAVES;
    constexpr int I_IN = (DM / 64) * (INW / 32), I_OUT = (DM / 64) * (DM / 32), I_F1 = (DM / 64) * (DFF / 32), I_F2 = (DFF / 64) * (DM / 32);
    constexpr int PER_LAYER = I_IN + I_OUT + I_F1 + I_F2;
    for (int it = gw; it < DEPTH * PER_LAYER; it += NGW) {
        const int li = it / PER_LAYER; int r = it % PER_LAYER;
        unsigned char* wb = a.ws + WS_W + (size_t)li * W_LAYER;
        if (r < I_IN) { p0_transpose_item(a.in[3] + (size_t)li * DM * INW, DM, INW, (bf16*)(wb + W_IN), a.in[1] + li * DM, scr, r, C.lane); continue; } r -= I_IN;
        if (r < I_OUT) { p0_transpose_item(a.in[11] + (size_t)li * DM * DM, DM, DM, (bf16*)(wb + W_OUT), nullptr, scr, r, C.lane); continue; } r -= I_OUT;
        if (r < I_F1) { p0_transpose_item(a.in[14] + (size_t)li * DM * DFF, DM, DFF, (bf16*)(wb + W_FF1), a.in[12] + li * DM, scr, r, C.lane); continue; } r -= I_F1;
        p0_transpose_item(a.in[15] + (size_t)li * DFF * DM, DFF, DM, (bf16*)(wb + W_FF2), nullptr, scr, r, C.lane);
    }
    if (C.blk == 0 && C.tid < DEPTH) ((unsigned*)a.ws)[64 * C.tid] = 0u;
    const float* x = a.in[0]; bf16* xb = (bf16*)(a.ws + WS_XB); float* rinv = (float*)(a.ws + WS_RINV);
    for (int m = gw; m < M; m += NGW) {
        const f32x4* xr = (const f32x4*)(x + (size_t)m * DM) + C.lane; unsigned long long* o8 = (unsigned long long*)(xb + (size_t)m * DM) + C.lane; float s = 0.f;
#pragma unroll
        for (int j = 0; j < 8; ++j) { const f32x4 v = xr[64 * j]; s += (v.x * v.x + v.y * v.y) + (v.z * v.z + v.w * v.w);
            o8[64 * j] = (unsigned long long)pk2(v.x, v.y) | ((unsigned long long)pk2(v.z, v.w) << 32); }
        s = wave_sum(s);
        if (C.lane == 0) rinv[m] = 1.f / sqrtf(s * (1.f / DM) + NORM_EPS);
    }
}

__device__ __forceinline__ void resid_phase(const Ctx& C, const Args& a, const float* xold, const float* y, const float* g) {
    const int gw = C.blk * NWAVES + C.wave, NGW = C.G * NWAVES;
    const float* ssq = (const float*)(a.ws + WS_SSQ); bf16* xb = (bf16*)(a.ws + WS_XB); float* rinv = (float*)(a.ws + WS_RINV);
    for (int m = gw; m < M; m += NGW) {
        float p = (C.lane < 32) ? ssq[(size_t)m * 32 + C.lane] : 0.f; p = wave_sum(p);
        const float rs = 1.f / sqrtf(p * (1.f / DM) + NORM_EPS);
        const f32x4* xr = (const f32x4*)(xold + (size_t)m * DM) + C.lane; const f32x4* yr = (const f32x4*)(y + (size_t)m * DM) + C.lane; const f32x4* gr = (const f32x4*)g + C.lane;
        f32x4* orow = (f32x4*)(a.out + (size_t)m * DM) + C.lane; unsigned long long* o8 = (unsigned long long*)(xb + (size_t)m * DM) + C.lane; float s = 0.f;
#pragma unroll
        for (int j = 0; j < 8; ++j) { const f32x4 xv = xr[64 * j], yv = yr[64 * j], gv = gr[64 * j]; const f32x4 v = xv + yv * rs * gv;
            s += (v.x * v.x + v.y * v.y) + (v.z * v.z + v.w * v.w); orow[64 * j] = v;
            o8[64 * j] = (unsigned long long)pk2(v.x, v.y) | ((unsigned long long)pk2(v.z, v.w) << 32); }
        s = wave_sum(s);
        if (C.lane == 0) rinv[m] = 1.f / sqrtf(s * (1.f / DM) + NORM_EPS);
    }
}

__device__ __forceinline__ void att_key(const bf16* kp, const bf16* vp, float bias2, const float (&q)[64], float& m, float& l, float (&o)[64]) {
    float s = 0.f;
#pragma unroll
    for (int c = 0; c < 8; ++c) { const uint4 kk = ((const uint4*)kp)[c];
        s += q[8 * c + 0] * bf_lo(kk.x) + q[8 * c + 1] * bf_hi(kk.x) + q[8 * c + 2] * bf_lo(kk.y) + q[8 * c + 3] * bf_hi(kk.y)
           + q[8 * c + 4] * bf_lo(kk.z) + q[8 * c + 5] * bf_hi(kk.z) + q[8 * c + 6] * bf_lo(kk.w) + q[8 * c + 7] * bf_hi(kk.w); }
    s += bias2;
    if (s > m) { const float al = __builtin_amdgcn_exp2f(m - s); l *= al;
#pragma unroll
        for (int d = 0; d < 64; ++d) o[d] *= al;
        m = s; }
    const float p = __builtin_amdgcn_exp2f(s - m);
    l += p;
#pragma unroll
    for (int c = 0; c < 8; ++c) { const uint4 vv = ((const uint4*)vp)[c];
        o[8 * c + 0] += p * bf_lo(vv.x); o[8 * c + 1] += p * bf_hi(vv.x); o[8 * c + 2] += p * bf_lo(vv.y); o[8 * c + 3] += p * bf_hi(vv.y);
        o[8 * c + 4] += p * bf_lo(vv.z); o[8 * c + 5] += p * bf_hi(vv.z); o[8 * c + 6] += p * bf_lo(vv.w); o[8 * c + 7] += p * bf_hi(vv.w); }
}
__device__ __forceinline__ void load_q64(const bf16* qp, float sc, float (&q)[64]) {
#pragma unroll
    for (int c = 0; c < 8; ++c) { const uint4 qq = ((const uint4*)qp)[c];
        q[8 * c + 0] = sc * bf_lo(qq.x); q[8 * c + 1] = sc * bf_hi(qq.x); q[8 * c + 2] = sc * bf_lo(qq.y); q[8 * c + 3] = sc * bf_hi(qq.y);
        q[8 * c + 4] = sc * bf_lo(qq.z); q[8 * c + 5] = sc * bf_hi(qq.z); q[8 * c + 6] = sc * bf_lo(qq.w); q[8 * c + 7] = sc * bf_hi(qq.w); }
}
__device__ __forceinline__ void store64_bf16(bf16* op, const float (&o)[64]) {
#pragma unroll
    for (int c = 0; c < 8; ++c) { v4u w; w.x = pk2(o[8 * c + 0], o[8 * c + 1]); w.y = pk2(o[8 * c + 2], o[8 * c + 3]); w.z = pk2(o[8 * c + 4], o[8 * c + 5]); w.w = pk2(o[8 * c + 6], o[8 * c + 7]);
        ((v4u*)op)[c] = w; }
}

typedef float f32x16 __attribute__((ext_vector_type(16)));
typedef short v4i16_t __attribute__((ext_vector_type(4)));
typedef short bf16x8_t __attribute__((ext_vector_type(8)));
constexpr int D_KRS = 272, D_VRS = 320, D_KB = 64 * D_KRS, D_VB = 64 * D_VRS;
constexpr int D_K0 = 0, D_K1 = D_KB, D_V0 = 2 * D_KB, D_V1 = 2 * D_KB + D_VB;
__device__ __forceinline__ unsigned cvtpk(float lo, float hi) { unsigned r; asm volatile("v_cvt_pk_bf16_f32 %0, %1, %2" : "=v"(r) : "v"(lo), "v"(hi)); return r; }
__device__ __forceinline__ v4i16_t tr_read(LAS unsigned char* p) { return __builtin_amdgcn_ds_read_tr16_b64_v4i16((LAS v4i16_t*)p); }

__device__ __forceinline__ void diff_unit(const Ctx& C, const Args& a, int li, int bh, int qblk, float lam, float lam_init) {
    const bf16* proj = (const bf16*)(a.ws + WS_R + R_PROJ); bf16* mixed = (bf16*)(a.ws + WS_R + R_MIXED);
    const int b = bh >> 2, h = bh & 3;
    const int lane = C.lane, r32 = lane & 31, hi = lane >> 5, map = C.wave >> 2, sl = C.wave & 3;
    const int qw0 = qblk * 128 + 32 * sl, qpos = qw0 + r32;
    const bf16* kvbase = proj + (size_t)b * SEQ * INW;
    LAS unsigned char* lds = C.lds;
    bf16x8_t qf[4];
    { const bf16* qp = kvbase + (size_t)qpos * INW + C_BQ + h * 128 + map * 64 + 8 * hi;
#pragma unroll
      for (int d0 = 0; d0 < 4; ++d0) qf[d0] = *(const bf16x8_t*)(qp + 16 * d0); }
    const float slope2 = exp2f(-8.f * (float)(3 * h + 1) / 12.f) * LOG2E; const float C2 = 0.125f * LOG2E;
    f32x16 O[4];
#pragma unroll
    for (int i = 0; i < 4; ++i)
#pragma unroll
        for (int r = 0; r < 16; ++r) O[i][r] = 0.f;
    float m = -INFINITY, l = 0.f;
    const int NT = 2 * qblk + 2;
    v4u kreg[2], vreg[2];
#define D_GLOAD(t) do { _Pragma("unroll") for (int i_ = 0; i_ < 2; ++i_) { const int id_ = C.tid + 512 * i_, row_ = id_ >> 4, ch_ = id_ & 15; \
        const bf16* rp_ = kvbase + (size_t)((t) * 64 + row_) * INW + h * 128 + ch_ * 8; kreg[i_] = *(const v4u*)(rp_ + C_BK); vreg[i_] = *(const v4u*)(rp_ + C_BV); } } while (0)
#define D_LSTORE(buf) do { _Pragma("unroll") for (int i_ = 0; i_ < 2; ++i_) { const int id_ = C.tid + 512 * i_, row_ = id_ >> 4, ch_ = id_ & 15; \
        *(LAS v4u*)(lds + ((buf) ? D_K1 : D_K0) + row_ * D_KRS + ch_ * 16) = kreg[i_]; *(LAS v4u*)(lds + ((buf) ? D_V1 : D_V0) + row_ * D_VRS + ch_ * 16) = vreg[i_]; } } while (0)
    D_GLOAD(0); D_LSTORE(0);
    __syncthreads();
    const int koff = r32 * D_KRS + map * 128 + hi * 16;
    const int voff = (4 * hi + ((lane & 15) >> 2)) * D_VRS + (16 * ((lane >> 4) & 1) + 4 * (lane & 3)) * 2;
    for (int t = 0; t < NT; ++t) {
        const int buf = t & 1;
        if (t + 1 < NT) D_GLOAD(t + 1);
        const int k0 = t * 64;
        if (k0 <= qw0 + 31) {
            LAS unsigned char* kb_ = lds + (buf ? D_K1 : D_K0) + koff; LAS unsigned char* vb_ = lds + (buf ? D_V1 : D_V0) + voff;
            f32x16 p0, p1;
#pragma unroll
            for (int r = 0; r < 16; ++r) { p0[r] = 0.f; p1[r] = 0.f; }
#pragma unroll
            for (int d0 = 0; d0 < 4; ++d0) { const bf16x8_t kf0 = *(LAS bf16x8_t*)(kb_ + d0 * 32), kf1 = *(LAS bf16x8_t*)(kb_ + 32 * D_KRS + d0 * 32);
                p0 = __builtin_amdgcn_mfma_f32_32x32x16_bf16(kf0, qf[d0], p0, 0, 0, 0); p1 = __builtin_amdgcn_mfma_f32_32x32x16_bf16(kf1, qf[d0], p1, 0, 0, 0); }
            const float bb = slope2 * (float)(k0 + 4 * hi - qpos);
#pragma unroll
            for (int r = 0; r < 16; ++r) { const int c = (r & 3) + 8 * (r >> 2); p0[r] = fmaf(p0[r], C2, bb + slope2 * (float)c); p1[r] = fmaf(p1[r], C2, bb + slope2 * (float)(c + 32)); }
            if (k0 + 63 > qw0) {
#pragma unroll
                for (int r = 0; r < 16; ++r) { const int kp = k0 + 4 * hi + (r & 3) + 8 * (r >> 2); if (kp > qpos) p0[r] = -INFINITY; if (kp + 32 > qpos) p1[r] = -INFINITY; }
            }
            float tmax = fmaxf(p0[0], p1[0]);
#pragma unroll
            for (int r = 1; r < 16; ++r) tmax = fmaxf(tmax, fmaxf(p0[r], p1[r]));
            tmax = fmaxf(tmax, __shfl_xor(tmax, 32));
            const float mn = fmaxf(m, tmax), al = __builtin_amdgcn_exp2f(m - mn); m = mn;
            float rs = 0.f;
#pragma unroll
            for (int r = 0; r < 16; ++r) { p0[r] = __builtin_amdgcn_exp2f(p0[r] - mn); p1[r] = __builtin_amdgcn_exp2f(p1[r] - mn); rs += p0[r] + p1[r]; }
            l = l * al + rs;
#pragma unroll
            for (int i = 0; i < 4; ++i)
#pragma unroll
                for (int r = 0; r < 16; ++r) O[i][r] *= al;
            bf16x8_t pb[4];
            { v4u w;
              w.x = cvtpk(p0[0], p0[1]); w.y = cvtpk(p0[2], p0[3]); w.z = cvtpk(p0[4], p0[5]); w.w = cvtpk(p0[6], p0[7]); pb[0] = __builtin_bit_cast(bf16x8_t, w);
              w.x = cvtpk(p0[8], p0[9]); w.y = cvtpk(p0[10], p0[11]); w.z = cvtpk(p0[12], p0[13]); w.w = cvtpk(p0[14], p0[15]); pb[1] = __builtin_bit_cast(bf16x8_t, w);
              w.x = cvtpk(p1[0], p1[1]); w.y = cvtpk(p1[2], p1[3]); w.z = cvtpk(p1[4], p1[5]); w.w = cvtpk(p1[6], p1[7]); pb[2] = __builtin_bit_cast(bf16x8_t, w);
              w.x = cvtpk(p1[8], p1[9]); w.y = cvtpk(p1[10], p1[11]); w.z = cvtpk(p1[12], p1[13]); w.w = cvtpk(p1[14], p1[15]); pb[3] = __builtin_bit_cast(bf16x8_t, w); }
#pragma unroll
            for (int ks = 0; ks < 4; ++ks)
#pragma unroll
                for (int i = 0; i < 4; ++i) { LAS unsigned char* vp = vb_ + (16 * ks) * D_VRS + i * 64;
                    const v4i16_t t0 = tr_read(vp), t1 = tr_read(vp + 8 * D_VRS);
                    const bf16x8_t vf = (bf16x8_t){t0[0], t0[1], t0[2], t0[3], t1[0], t1[1], t1[2], t1[3]};
                    O[i] = __builtin_amdgcn_mfma_f32_32x32x16_bf16(vf, pb[ks], O[i], 0, 0, 0); }
        }
        if (t + 1 < NT) D_LSTORE(buf ^ 1);
        __syncthreads();
    }
#undef D_GLOAD
#undef D_LSTORE
    l += __shfl_xor(l, 32);
    { const float inv = 1.f / l;
#pragma unroll
      for (int i = 0; i < 4; ++i)
#pragma unroll
          for (int r = 0; r < 16; ++r) O[i][r] *= inv; }
    LAS float* X = (LAS float*)lds;
    if (map == 1) {
#pragma unroll
        for (int i = 0; i < 4; ++i)
#pragma unroll
            for (int r = 0; r < 16; ++r) X[(sl * 64 + i * 16 + r) * 64 + lane] = O[i][r];
    }
    __syncthreads();
    if (map == 0) {
        float ss = 0.f;
#pragma unroll
        for (int i = 0; i < 4; ++i)
#pragma unroll
            for (int r = 0; r < 16; ++r) { const float o = O[i][r] - lam * X[(sl * 64 + i * 16 + r) * 64 + lane]; O[i][r] = o; ss += o * o; }
        ss += __shfl_xor(ss, 32);
        const float rr = (1.f - lam_init) / sqrtf(ss * (1.f / 128.f) + NORM_EPS);
        const float* sg = a.in[7] + li * 128;
        bf16* orow = mixed + ((size_t)b * SEQ + qpos) * DM + 512 + h * 128;
#pragma unroll
        for (int i = 0; i < 4; ++i)
#pragma unroll
            for (int g = 0; g < 4; ++g) { const int d = i * 32 + 8 * g + 4 * hi; const f32x4 gv = *(const f32x4*)(sg + d);
                uint2 wv; wv.x = pk2(O[i][4 * g] * rr * gv.x, O[i][4 * g + 1] * rr * gv.y); wv.y = pk2(O[i][4 * g + 2] * rr * gv.z, O[i][4 * g + 3] * rr * gv.w);
                *(uint2*)(orow + d) = wv; }
    }
    __syncthreads();
}

constexpr int DL_VRS = 192, DL_VST = 32 * DL_VRS;
constexpr size_t DP_O = 0, DP_M = 32 * MiB, DP_L = 33 * MiB;
__device__ __forceinline__ void dil_tile(const Ctx& C, const bf16* kvb, int dil, int rc, int J0, float slope2, LAS unsigned char* vst, float& m, float& l, f32x16 (&O)[2]) {
    const int lane = C.lane, r32 = lane & 31, hi = lane >> 5;
    const int J = J0 + r32; const size_t t = (size_t)dil * J + rc;
    bf16x8_t qf[4];
#pragma unroll
    for (int d0 = 0; d0 < 4; ++d0) qf[d0] = *(const bf16x8_t*)(kvb + t * INW + C_CQ + 16 * d0 + 8 * hi);
    m = -INFINITY; l = 0.f;
#pragma unroll
    for (int i = 0; i < 2; ++i)
#pragma unroll
        for (int r = 0; r < 16; ++r) O[i][r] = 0.f;
    const int c_hi = J0 >> 5; const int c_lo = (c_hi - 4 < 0) ? 0 : c_hi - 4;
    const float sd2 = slope2 * (float)dil, C2 = 0.125f * LOG2E;
    const int voff = (4 * hi + ((lane & 15) >> 2)) * DL_VRS + (16 * ((lane >> 4) & 1) + 4 * (lane & 3)) * 2;
    bf16x8_t kf[4]; v4u vr[4];
#define DL_LOADKV(c) do { const bf16* kp_ = kvb + ((size_t)dil * (32 * (c) + r32) + rc) * INW + C_CK + 8 * hi; \
        _Pragma("unroll") for (int d0 = 0; d0 < 4; ++d0) kf[d0] = *(const bf16x8_t*)(kp_ + 16 * d0); \
        _Pragma("unroll") for (int i_ = 0; i_ < 4; ++i_) { const int p_ = lane + 64 * i_; vr[i_] = *(const v4u*)(kvb + ((size_t)dil * (32 * (c) + (p_ >> 3)) + rc) * INW + C_CV + (p_ & 7) * 8); } } while (0)
    DL_LOADKV(c_lo);
    for (int c = c_lo; c <= c_hi; ++c) {
        bf16x8_t kc[4]; v4u vc[4];
#pragma unroll
        for (int i = 0; i < 4; ++i) { kc[i] = kf[i]; vc[i] = vr[i]; }
        if (c < c_hi) DL_LOADKV(c + 1);
#pragma unroll
        for (int i = 0; i < 4; ++i) { const int p_ = lane + 64 * i; *(LAS v4u*)(vst + (p_ >> 3) * DL_VRS + (p_ & 7) * 16) = vc[i]; }
        f32x16 p;
#pragma unroll
        for (int r = 0; r < 16; ++r) p[r] = 0.f;
#pragma unroll
        for (int d0 = 0; d0 < 4; ++d0) p = __builtin_amdgcn_mfma_f32_32x32x16_bf16(kc[d0], qf[d0], p, 0, 0, 0);
        const int jb = 32 * c + 4 * hi;
        const float bb = sd2 * (float)(jb - J);
#pragma unroll
        for (int r = 0; r < 16; ++r) p[r] = fmaf(p[r], C2, bb + sd2 * (float)((r & 3) + 8 * (r >> 2)));
        if (c == c_hi) {
#pragma unroll
            for (int r = 0; r < 16; ++r) if (jb + (r & 3) + 8 * (r >> 2) > J) p[r] = -INFINITY;
        }
        if (c == c_hi - 4) {
#pragma unroll
            for (int r = 0; r < 16; ++r) if (jb + (r & 3) + 8 * (r >> 2) < J - 128) p[r] = -INFINITY;
        }
        float tmax = p[0];
#pragma unroll
        for (int r = 1; r < 16; ++r) tmax = fmaxf(tmax, p[r]);
        tmax = fmaxf(tmax, __shfl_xor(tmax, 32));
        const float mn = fmaxf(m, tmax), al = __builtin_amdgcn_exp2f(m - mn); m = mn;
        float rs = 0.f;
#pragma unroll
        for (int r = 0; r < 16; ++r) { p[r] = __builtin_amdgcn_exp2f(p[r] - mn); rs += p[r]; }
        l = l * al + rs;
#pragma unroll
        for (int i = 0; i < 2; ++i)
#pragma unroll
            for (int r = 0; r < 16; ++r) O[i][r] *= al;
        bf16x8_t pb[2];
        { v4u w;
          w.x = cvtpk(p[0], p[1]); w.y = cvtpk(p[2], p[3]); w.z = cvtpk(p[4], p[5]); w.w = cvtpk(p[6], p[7]); pb[0] = __builtin_bit_cast(bf16x8_t, w);
          w.x = cvtpk(p[8], p[9]); w.y = cvtpk(p[10], p[11]); w.z = cvtpk(p[12], p[13]); w.w = cvtpk(p[14], p[15]); pb[1] = __builtin_bit_cast(bf16x8_t, w); }
        asm volatile("s_waitcnt lgkmcnt(0)" ::: "memory");
#pragma unroll
        for (int ks = 0; ks < 2; ++ks)
#pragma unroll
            for (int i = 0; i < 2; ++i) { LAS unsigned char* vp = vst + voff + (16 * ks) * DL_VRS + i * 64;
                const v4i16_t t0 = tr_read(vp), t1 = tr_read(vp + 8 * DL_VRS);
                const bf16x8_t vf = (bf16x8_t){t0[0], t0[1], t0[2], t0[3], t1[0], t1[1], t1[2], t1[3]};
                O[i] = __builtin_amdgcn_mfma_f32_32x32x16_bf16(vf, pb[ks], O[i], 0, 0, 0); }
        asm volatile("s_waitcnt lgkmcnt(0)" ::: "memory");
    }
#undef DL_LOADKV
    l += __shfl_xor(l, 32);
}
__device__ __forceinline__ void dil_unit(const Ctx& C, const Args& a, int b, int h, int seg) {
    const bf16* proj = (const bf16*)(a.ws + WS_R + R_PROJ); bf16* mixed = (bf16*)(a.ws + WS_R + R_MIXED);
    unsigned char* part = a.ws + WS_R + R_Y1;
    float* PO = (float*)(part + DP_O); float* PM = (float*)(part + DP_M); float* PL = (float*)(part + DP_L);
    const bf16* kvb = proj + (size_t)b * SEQ * INW + h * 64;
    const int lane = C.lane, r32 = lane & 31, hi = lane >> 5;
    const int sidx = 3 * (h >> 1) + 1 + (h & 1);
    const float slope2 = exp2f(-8.f * (float)(sidx + 1) / 12.f) * LOG2E;
    LAS unsigned char* vst = C.lds + C.wave * DL_VST;
    const size_t qbase = (size_t)(b * 8 + h) * SEQ;
    float m, l; f32x16 O[2];
#pragma unroll 1
    for (int i = 0; i < 4; ++i) { const int tl = C.wave * 4 + i, pat = tl >> 4, k = tl & 15;
        const int dil = pat ? 4 : 1, rc = pat ? (k >> 2) : 0, J0 = pat ? (128 * seg + 32 * (k & 3)) : (512 * seg + 32 * k);
        dil_tile(C, kvb, dil, rc, J0, slope2, vst, m, l, O);
        const size_t idx = (size_t)pat * 65536 + qbase + (size_t)dil * (J0 + r32) + rc;
#pragma unroll
        for (int ii = 0; ii < 2; ++ii)
#pragma unroll
            for (int g = 0; g < 4; ++g) *(f32x4*)(PO + idx * 64 + ii * 32 + 8 * g + 4 * hi) = (f32x4){O[ii][4 * g], O[ii][4 * g + 1], O[ii][4 * g + 2], O[ii][4 * g + 3]};
        if (hi == 0) { PM[idx] = m; PL[idx] = l; } }
    __threadfence(); __syncthreads(); __threadfence();
#pragma unroll 1
    for (int i = 0; i < 2; ++i) { const int rc = C.wave * 2 + i, J0 = 32 * seg;
        dil_tile(C, kvb, 16, rc, J0, slope2, vst, m, l, O);
        const size_t t = (size_t)16 * (J0 + r32) + rc, i1 = qbase + t, i2 = 65536 + qbase + t;
        const float m1 = PM[i1], l1 = PL[i1], m2 = PM[i2], l2 = PL[i2];
        const float mx = fmaxf(m, fmaxf(m1, m2));
        const float w3 = __builtin_amdgcn_exp2f(m - mx), w1 = __builtin_amdgcn_exp2f(m1 - mx), w2 = __builtin_amdgcn_exp2f(m2 - mx);
        const float inv = 1.f / (w3 * l + w1 * l1 + w2 * l2);
        bf16* orow = mixed + ((size_t)b * SEQ + t) * DM + 1024 + h * 64;
#pragma unroll
        for (int ii = 0; ii < 2; ++ii)
#pragma unroll
            for (int g = 0; g < 4; ++g) { const int d = ii * 32 + 8 * g + 4 * hi; const f32x4 o1 = *(const f32x4*)(PO + i1 * 64 + d), o2 = *(const f32x4*)(PO + i2 * 64 + d);
                const float v0 = (w3 * O[ii][4 * g] + w1 * o1.x + w2 * o2.x) * inv, v1 = (w3 * O[ii][4 * g + 1] + w1 * o1.y + w2 * o2.y) * inv;
                const float v2 = (w3 * O[ii][4 * g + 2] + w1 * o1.z + w2 * o2.z) * inv, v3 = (w3 * O[ii][4 * g + 3] + w1 * o1.w + w2 * o2.w) * inv;
                uint2 wv; wv.x = pk2(v0, v1); wv.y = pk2(v2, v3); *(uint2*)(orow + d) = wv; } }
    __syncthreads();
}

__device__ __forceinline__ void gmlp_unit(const Ctx& C, const Args& a, int li, int unit) {
    const bf16* proj = (const bf16*)(a.ws + WS_R + R_PROJ); bf16* mixed = (bf16*)(a.ws + WS_R + R_MIXED);
    const size_t row0 = (size_t)unit * 128;
    LAS bf16* vn = (LAS bf16*)C.lds;
    for (int tt = 0; tt < 16; ++tt) { const int t = C.wave * 16 + tt;
        const uint4 vv = *(const uint4*)(proj + (row0 + t) * INW + C_AV + C.lane * 8);
        float v[8] = {bf_lo(vv.x), bf_hi(vv.x), bf_lo(vv.y), bf_hi(vv.y), bf_lo(vv.z), bf_hi(vv.z), bf_lo(vv.w), bf_hi(vv.w)}; float s = 0.f;
#pragma unroll
        for (int e = 0; e < 8; ++e) { v[e] = gelu_tanh(v[e]); s += v[e]; }
        const float mean = wave_sum(s) * (1.f / 512.f); float s2 = 0.f;
#pragma unroll
        for (int e = 0; e < 8; ++e) { v[e] -= mean; s2 += v[e] * v[e]; }
        const float rstd = 1.f / sqrtf(wave_sum(s2) * (1.f / 512.f) + NORM_EPS);
        v4u w; w.x = pk2(v[0] * rstd, v[1] * rstd); w.y = pk2(v[2] * rstd, v[3] * rstd); w.z = pk2(v[4] * rstd, v[5] * rstd); w.w = pk2(v[6] * rstd, v[7] * rstd);
        *(LAS v4u*)(vn + t * 512 + C.lane * 8) = w; }
    __syncthreads();
    const int ch = C.tid, g = C.wave;
    const float* W = a.in[4] + ((size_t)li * 8 + g) * 128 * 128; const float* bs = a.in[5] + ((size_t)li * 8 + g) * 128;
    { const unsigned long long wa = (unsigned long long)W; const unsigned lo_ = __builtin_amdgcn_readfirstlane((unsigned)wa), hi_ = __builtin_amdgcn_readfirstlane((unsigned)(wa >> 32));
      W = (const float*)(((unsigned long long)hi_ << 32) | lo_); }
    for (int tb = 0; tb < 4; ++tb) {
        float acc[32];
#pragma unroll
        for (int i = 0; i < 32; ++i) acc[i] = 0.f;
        const int send = tb * 32 + 31;
        for (int s = 0; s <= send; ++s) { const float xv = bf1(vn[s * 512 + ch]);
#pragma unroll
            for (int i = 0; i < 32; ++i) { const int t = tb * 32 + i; const float wv = (t >= s) ? W[t * 128 + s] : 0.f; acc[i] += wv * xv; } }
#pragma unroll
        for (int i = 0; i < 32; ++i) { const int t = tb * 32 + i; const float z = acc[i] + bs[t];
            const float u = gelu_tanh(bf1(proj[(row0 + t) * INW + C_AU + ch]));
            mixed[(row0 + t) * DM + ch] = (bf16)f2bf(u * z); }
    }
    __syncthreads();
}

__device__ __forceinline__ void conv_unit(const Ctx& C, const Args& a, int li, int unit) {
    const bf16* proj = (const bf16*)(a.ws + WS_R + R_PROJ); bf16* mixed = (bf16*)(a.ws + WS_R + R_MIXED);
    const int b = unit >> 6, t0 = (unit & 63) * 32, c = C.tid;
    LAS float* hs = (LAS float*)C.lds;
    const float* cw = a.in[8] + (size_t)li * 31 * 512;
#pragma unroll 2
    for (int i = 0; i < 62; ++i) { const int s = t0 - 30 + i; float hv = 0.f;
        if (s >= 0) { const bf16* pr = proj + ((size_t)b * SEQ + s) * INW; hv = bf1(pr[C_DA + c]) * sigmoidf_(bf1(pr[C_DG + c])); }
        hs[i * 512 + c] = hv; }
    float w[31];
#pragma unroll
    for (int k = 0; k < 31; ++k) w[k] = cw[k * 512 + c];
    const float bd = a.in[9][li * 512 + c];
#pragma unroll 1
    for (int j = 0; j < 32; ++j) { float acc = bd;
#pragma unroll
        for (int k = 0; k < 31; ++k) acc += w[k] * hs[(j + k) * 512 + c];
        hs[j * 512 + c] = acc; }
    __syncthreads();
    const float* ng = a.in[10] + li * 512 + C.lane * 8;
#pragma unroll 1
    for (int jj = 0; jj < 4; ++jj) { const int j = C.wave * 4 + jj; float v[8]; float ss = 0.f;
#pragma unroll
        for (int e = 0; e < 8; ++e) { v[e] = hs[j * 512 + C.lane * 8 + e]; ss += v[e] * v[e]; }
        const float r = 1.f / sqrtf(wave_sum(ss) * (1.f / 512.f) + NORM_EPS);
#pragma unroll
        for (int e = 0; e < 8; ++e) { const float hn = v[e] * r * ng[e]; v[e] = hn * sigmoidf_(hn); }
        v4u wv; wv.x = pk2(v[0], v[1]); wv.y = pk2(v[2], v[3]); wv.z = pk2(v[4], v[5]); wv.w = pk2(v[6], v[7]);
        *(v4u*)(mixed + ((size_t)b * SEQ + t0 + j) * DM + 1536 + C.lane * 8) = wv; }
    __syncthreads();
}

__device__ __forceinline__ int next_item(const Ctx& C, unsigned* ctr) {
    volatile LAS unsigned* word = (volatile LAS unsigned*)(C.lds + RING_BYTES);
    __syncthreads();
    if (C.tid == 0) *word = atomicAdd(ctr, 1u);
    __syncthreads();
    return (int)*word;
}
__device__ __forceinline__ void mixer_phase(const Ctx& C0, const Args& a, int li) {
    const float* lp = a.in[6] + li * 256;
    const float d01 = wave_sum(lp[C0.lane] * lp[64 + C0.lane]), d23 = wave_sum(lp[128 + C0.lane] * lp[192 + C0.lane]);
    const float lam_init = 0.8f - 0.6f * expf(-0.3f * (float)li);
    const float lam = expf(d01) - expf(d23) + lam_init;
    unsigned* ctr = (unsigned*)a.ws + 64 * li;
    for (;;) {
        int it = next_item(C0, ctr);
        if (it >= 64 + 256 + 128 + 256) break;
        Ctx C = C0; { int t_ = C0.tid; asm volatile("" : "+v"(t_)); C.tid = t_; C.lane = t_ & 63; }
        if (it < 64) { gmlp_unit(C, a, li, it); continue; } it -= 64;
        if (it < 256) { diff_unit(C, a, li, it & 15, 15 - (it >> 4), lam, lam_init); continue; } it -= 256;
        if (it < 128) { dil_unit(C, a, it >> 5, (it >> 2) & 7, it & 3); continue; } it -= 128;
        conv_unit(C, a, li, it);
    }
}

__global__ void __launch_bounds__(NWAVES * 64, 2) mk_fwd(Args args) {
    extern __shared__ __attribute__((aligned(16))) unsigned char lds[];
    Ctx C; C.tid = threadIdx.x; C.lane = C.tid & 63; C.wave = __builtin_amdgcn_readfirstlane(C.tid >> 6); C.G = gridDim.x; C.blk = blockIdx.x; C.lds = (LAS unsigned char*)lds;
    const int lo = args.ph_lo, hi = args.ph_hi;
    unsigned char* ws = args.ws;
    float* rinv = (float*)(ws + WS_RINV); float* ssq = (float*)(ws + WS_SSQ);
    bf16* xb = (bf16*)(ws + WS_XB); bf16* proj = (bf16*)(ws + WS_R + R_PROJ); bf16* mixed = (bf16*)(ws + WS_R + R_MIXED);
    float* y1 = (float*)(ws + WS_R + R_Y1); float* y2 = (float*)(ws + WS_R + R_Y2); bf16* fb = (bf16*)(ws + WS_R + R_F);
#define IN(k) (lo <= (k) && (k) < hi)
#define SEAM(k) do { if (IN(k) && IN((k) + 1)) { cg::this_grid().sync(); } } while (0)
    if (IN(0)) { p0_prologue(C, args); }
    SEAM(0);
    for (int li = 0; li < DEPTH; ++li) {
        const int p = 1 + 7 * li;
        unsigned char* wb = ws + WS_W + (size_t)li * W_LAYER;
        asm volatile("" : "+s"(wb), "+s"(xb), "+s"(proj), "+s"(mixed), "+s"(y1), "+s"(y2), "+s"(fb), "+s"(rinv), "+s"(ssq));
        Ctx Cl; { int t_ = threadIdx.x, b_ = blockIdx.x, g_ = gridDim.x; asm volatile("" : "+v"(t_), "+s"(b_), "+s"(g_));
            Cl.tid = t_; Cl.lane = t_ & 63; Cl.wave = __builtin_amdgcn_readfirstlane(t_ >> 6); Cl.G = g_; Cl.blk = b_; Cl.lds = (LAS unsigned char*)lds; }
        if (IN(p + 0)) {
            pg8::Gemm g{xb, (const bf16*)(wb + W_IN), M, INW, DM}; pg8::StaticOrder S; S.init(M, INW, Cl.G, Cl.blk);
            pg8::EpiRowScaleBf16 E{proj, INW, rinv, 0};
            pg8::gemm_phase<pg8::EpiRowScaleBf16, pg8::StaticOrder, true, true>(Cl.lds, g, S, E, Cl.tid);
        }
        SEAM(p + 0);
        if (IN(p + 1)) { mixer_phase(Cl, args, li); }
        SEAM(p + 1);
        if (IN(p + 2)) {
            pg8::Gemm g{mixed, (const bf16*)(wb + W_OUT), M, DM, DM}; pg8::StaticOrder S; S.init(M, DM, Cl.G, Cl.blk);
            pg8::EpiF32Ssq E{y1, DM, ssq};
            pg8::gemm_phase<pg8::EpiF32Ssq, pg8::StaticOrder, true, true>(Cl.lds, g, S, E, Cl.tid);
        }
        SEAM(p + 2);
        if (IN(p + 3)) { resid_phase(Cl, args, li == 0 ? args.in[0] : args.out, y1, args.in[2] + li * DM); }
        SEAM(p + 3);
        if (IN(p + 4)) {
            pg8::Gemm g{xb, (const bf16*)(wb + W_FF1), M, DFF, DM}; pg8::StaticOrder S; S.init(M, DFF, Cl.G, Cl.blk);
            pg8::EpiRowScaleBf16 E{fb, DFF, rinv, 1};
            pg8::gemm_phase<pg8::EpiRowScaleBf16, pg8::StaticOrder, true, true>(Cl.lds, g, S, E, Cl.tid);
        }
        SEAM(p + 4);
        if (IN(p + 5)) {
            pg8::Gemm g{fb, (const bf16*)(wb + W_FF2), M, DM, DFF}; pg8::StaticOrder S; S.init(M, DM, Cl.G, Cl.blk);
            pg8::EpiF32Ssq E{y2, DM, ssq};
            pg8::gemm_phase<pg8::EpiF32Ssq, pg8::StaticOrder, true, true>(Cl.lds, g, S, E, Cl.tid);
        }
        SEAM(p + 5);
        if (IN(p + 6)) { resid_phase(Cl, args, args.out, y2, args.in[13] + li * DM); }
        SEAM(p + 6);
    }
#undef IN
#undef SEAM
}

extern "C" void kernel_launch(void* const* d_in, const int* in_sizes, int n_in, void* d_out, int out_size, void* d_ws, size_t ws_size, hipStream_t stream) {
    static int grid = 0;
    if (grid == 0) {
        if (n_in != 16 || in_sizes[0] != M * DM || out_size != M * DM || ws_size < WS_END) { fprintf(stderr, "kernel_launch: unexpected shapes (n_in %d, in0 %d, out %d, ws %zu); nothing launched\n", n_in, n_in > 0 ? in_sizes[0] : -1, out_size, ws_size); grid = -1; return; }
        int dev = 0, cus = 0, per_cu = 0;
        if (hipGetDevice(&dev) != hipSuccess || hipDeviceGetAttribute(&cus, hipDeviceAttributeMultiprocessorCount, dev) != hipSuccess) { grid = -1; return; }
        if (hipFuncSetAttribute((const void*)mk_fwd, hipFuncAttributeMaxDynamicSharedMemorySize, LDS_BYTES) != hipSuccess) { fprintf(stderr, "kernel_launch: hipFuncSetAttribute failed\n"); grid = -1; return; }
        if (hipOccupancyMaxActiveBlocksPerMultiprocessor(&per_cu, (const void*)mk_fwd, NWAVES * 64, LDS_BYTES) != hipSuccess || per_cu < 1) { fprintf(stderr, "kernel_launch: occupancy query says %d\n", per_cu); per_cu = 1; }
        (void)hipGetLastError();
        grid = cus;
    }
    if (grid < 0) return;
    Args a{};
    for (int i = 0; i < 16; ++i) a.in[i] = (const float*)d_in[i];
    a.out = (float*)d_out; a.ws = (unsigned char*)d_ws;
    if (N_LAUNCHES == 1) {
        a.ph_lo = 0; a.ph_hi = NPHASE;
        void* kargs[] = {&a};
        hipError_t e = hipLaunchCooperativeKernel((const void*)mk_fwd, dim3(grid), dim3(NWAVES * 64), kargs, LDS_BYTES, stream);
        if (e != hipSuccess) fprintf(stderr, "kernel_launch: cooperative launch failed: %s (grid %d)\n", hipGetErrorString(e), grid);
    } else {
        for (int k = 0; k < NPHASE; ++k) {
            a.ph_lo = k; a.ph_hi = k + 1;
            hipLaunchKernelGGL(mk_fwd, dim3(grid), dim3(NWAVES * 64), LDS_BYTES, stream, a);
        }
    }
}
```

```cpp
#include <hip/hip_runtime.h>
#include <hip/hip_cooperative_groups.h>
#include <cstdio>
#include <cstdint>
namespace cg = cooperative_groups;

#ifndef REP_GMLP
#define REP_GMLP 1
#endif
#ifndef REP_DIFF
#define REP_DIFF 1
#endif
#ifndef REP_DIL
#define REP_DIL 1
#endif
#ifndef REP_CONV
#define REP_CONV 1
#endif
#ifndef GEMM_REPS
#define GEMM_REPS 1
#endif
#ifndef MK_N_LAUNCHES
#define MK_N_LAUNCHES 1
#endif

namespace pg8 {
#define PG8_LAS __attribute__((address_space(3)))
typedef unsigned short bf16_t;
typedef short bf16x8 __attribute__((ext_vector_type(8)));
typedef float f32x4 __attribute__((ext_vector_type(4)));
typedef unsigned u32x4 __attribute__((ext_vector_type(4)));
constexpr int BM = 256, BK = 64, HALF = 128, HTB = HALF * BK * 2  , STAGE_BYTES = 8 * HTB, NXCD = 8, WGM = 8;

__host__ __device__ __forceinline__ int lds_byte(int r, int c) { const int st = (r >> 4) * 2 + (c >> 5), rr = r & 15, cc = c & 31, ob = rr * 64 + cc * 2; return st * 1024 + (ob ^ (((ob >> 9) & 1) << 5)); }
__host__ __device__ __forceinline__ void stage_rc(int b, int& R, int& C) { const int st = b / 1024, sb = b % 1024, swz = sb ^ (((sb >> 9) & 1) << 5); R = (st >> 1) * 16 + swz / 64; C = (st & 1) * 32 + (swz % 64) / 2; }
__host__ __device__ __forceinline__ int perm32(int rho) { const int n = rho >> 4, i = rho & 15; return 8 * (i >> 2) + 4 * n + (i & 3); }

struct Unit { int pm, pn; };
struct Gemm { const bf16_t* A; const bf16_t* Bt; int M, N, K; };

struct StaticOrder {
    int nM, nN, nwg, G, c;
    __host__ __device__ void init(int M, int N, int G_, int c_) { nM = M / BM; nN = N / BM; nwg = nM * nN; G = G_; c = c_; }
    __host__ __device__ bool next(int i, Unit& u) const {
        const long L = (long)i * G + c; if (L >= nwg) return false;
        int wgid = (int)L; { const int q = nwg / NXCD, r = nwg % NXCD, xcd = wgid % NXCD, off = wgid / NXCD; wgid = (xcd < r ? xcd * (q + 1) : r * (q + 1) + (xcd - r) * q) + off; }
        const int nig = WGM * nN, gid = wgid / nig, fm = gid * WGM, gsz = (nM - fm) < WGM ? (nM - fm) : WGM;
        u.pm = fm + ((wgid % nig) % gsz); u.pn = (wgid % nig) / gsz; return true;
    }
    __device__ __forceinline__ void a_ready(const Unit&) const {}
    __device__ __forceinline__ void done(const Unit&) const {}
};

__device__ __forceinline__ unsigned cvt_pk_bf16(float lo, float hi) { unsigned r; asm volatile("v_cvt_pk_bf16_f32 %0, %1, %2" : "=v"(r) : "v"(lo), "v"(hi)); return r; }

struct EpiRowScaleBf16 {
    static constexpr bool PERM = true, AFTER_DRAIN = false;
    bf16_t* O; int ldc; const float* rinv; int act;
    __device__ __forceinline__ void operator()(const f32x4 (&acc)[2][2][4][2], const Unit& u, int wr, int wc, int fr, int fq) const {
        const int row0 = u.pm * BM + wr * 64 + fr; const int col0 = u.pn * BM + wc * 32 + 8 * fq;
#pragma unroll
        for (int ai = 0; ai < 2; ++ai)
#pragma unroll
            for (int m = 0; m < 4; ++m) { const int row = row0 + ai * HALF + m * 16; const float s = rinv[row]; bf16_t* rowp = O + (size_t)row * ldc + col0;
#pragma unroll
                for (int bj = 0; bj < 2; ++bj) { f32x4 v0 = acc[ai][bj][m][0] * s, v1 = acc[ai][bj][m][1] * s;
                    if (act) {
#pragma unroll
                        for (int e = 0; e < 4; ++e) { const float a = fmaxf(v0[e], 0.f), b = fmaxf(v1[e], 0.f); v0[e] = a * a; v1[e] = b * b; } }
                    u32x4 w; w.x = cvt_pk_bf16(v0[0], v0[1]); w.y = cvt_pk_bf16(v0[2], v0[3]); w.z = cvt_pk_bf16(v1[0], v1[1]); w.w = cvt_pk_bf16(v1[2], v1[3]);
                    *(u32x4*)(rowp + bj * HALF) = w; } }
    }
};
struct EpiF32Ssq {
    static constexpr bool PERM = false, AFTER_DRAIN = false;
    float* Y; int ldc; float* ssq;
    __device__ __forceinline__ void operator()(const f32x4 (&acc)[2][2][4][2], const Unit& u, int wr, int wc, int fr, int fq) const {
        const int row0 = u.pm * BM + wr * 64 + fr; const int col0 = u.pn * BM + wc * 32 + 4 * fq;
#pragma unroll
        for (int ai = 0; ai < 2; ++ai)
#pragma unroll
            for (int m = 0; m < 4; ++m) { const int row = row0 + ai * HALF + m * 16; float* rowp = Y + (size_t)row * ldc + col0; float s = 0.f;
#pragma unroll
                for (int bj = 0; bj < 2; ++bj)
#pragma unroll
                    for (int n = 0; n < 2; ++n) { const f32x4 v = acc[ai][bj][m][n]; s += (v[0] * v[0] + v[1] * v[1]) + (v[2] * v[2] + v[3] * v[3]); *(f32x4*)(rowp + bj * HALF + n * 16) = v; }
                s += __shfl_xor(s, 16); s += __shfl_xor(s, 32);
                if (fq == 0) ssq[(size_t)row * 32 + u.pn * 4 + wc] = s; }
    }
};

template <class Epi, class Sched, bool ALIGN_EPI = false, bool SP2 = false>
__device__ __forceinline__ void gemm_phase(PG8_LAS unsigned char* lds, const Gemm g, const Sched& S, const Epi& E, const int tid) {
    const int wid = __builtin_amdgcn_readfirstlane(tid >> 6), lane = tid & 63, wr = wid >> 2, wc = wid & 3, fr = lane & 15, fq = lane >> 4;
    const int K = g.K, nt = K / BK;
    unsigned voffA[2], voffB[2];
#pragma unroll
    for (int i = 0; i < 2; ++i) { int R, C; stage_rc(tid * 16 + i * 8192, R, C); const int Rb = Epi::PERM ? ((R & ~31) + perm32(R & 31)) : R;
        voffA[i] = (unsigned)(R * K + C) * 2u; voffB[i] = (unsigned)(Rb * K + C) * 2u; }
    const size_t kstep = (size_t)(BK * 2);
    const size_t hstep = (size_t)HALF * K * 2;
    const size_t tstep = 2 * hstep;
    const unsigned ldsw = (unsigned)wid * 1024u;
    const int aoff = lds_byte(wr * 64 + fr, fq * 8), boff = lds_byte(wc * 32 + fr, fq * 8);
#define PG8_SA(b, h) (((b) * 2 + (h)) * HTB)
#define PG8_SB(b, h) ((4 + (b) * 2 + (h)) * HTB)
#define PG8_STAGE(bufoff, gbase, voff) do { _Pragma("unroll") for (int _i = 0; _i < 2; ++_i) \
        __builtin_amdgcn_global_load_lds((const unsigned*)((const char*)(gbase) + (voff)[_i]), (PG8_LAS unsigned*)(lds + (bufoff) + ldsw + _i * 8192), 16, 0, 0); } while (0)
#define PG8_LDA(dst, b, h) do { _Pragma("unroll") for (int m = 0; m < 4; ++m) _Pragma("unroll") for (int k = 0; k < 2; ++k) dst[m][k] = *(const PG8_LAS bf16x8*)(lds + PG8_SA(b, h) + aoff + m * 2048 + k * 1024); } while (0)
#define PG8_LDB(dst, b, h) do { _Pragma("unroll") for (int n = 0; n < 2; ++n) _Pragma("unroll") for (int k = 0; k < 2; ++k) dst[n][k] = *(const PG8_LAS bf16x8*)(lds + PG8_SB(b, h) + boff + n * 2048 + k * 1024); } while (0)
#define PG8_MMA(ai, bj, At, Bt) do { __builtin_amdgcn_s_setprio(1); _Pragma("unroll") for (int m = 0; m < 4; ++m) _Pragma("unroll") for (int n = 0; n < 2; ++n) _Pragma("unroll") for (int k = 0; k < 2; ++k) \
        acc[ai][bj][m][n] = __builtin_amdgcn_mfma_f32_16x16x32_bf16(Bt[n][k], At[m][k], acc[ai][bj][m][n], 0, 0, 0); __builtin_amdgcn_s_setprio(0); } while (0)
#define PG8_WAIT_V(n) asm volatile("s_waitcnt vmcnt(" #n ")" ::: "memory")
#define PG8_WAIT_L(n) asm volatile("s_waitcnt lgkmcnt(" #n ")" ::: "memory")
#define PG8_BAR __builtin_amdgcn_s_barrier()
#define PG8_SCHED __builtin_amdgcn_sched_barrier(0)
    Unit cur, nxt; int ui = 0;
    if (!S.next(0, cur)) return;
    f32x4 acc[2][2][4][2];
#pragma unroll
    for (int a = 0; a < 2; ++a)
#pragma unroll
        for (int b = 0; b < 2; ++b)
#pragma unroll
            for (int m = 0; m < 4; ++m)
#pragma unroll
                for (int n = 0; n < 2; ++n) acc[a][b][m][n] = (f32x4){0.f, 0.f, 0.f, 0.f};
    bf16x8 At[4][2], B0[2][2], B1[2][2];
    const char* cA = (const char*)g.A + (size_t)cur.pm * tstep; const char* cB = (const char*)g.Bt + (size_t)cur.pn * tstep;
    S.a_ready(cur);
    if constexpr (SP2) {
        PG8_STAGE(PG8_SB(0, 0), cB, voffB); PG8_STAGE(PG8_SB(0, 1), cB + hstep, voffB); PG8_STAGE(PG8_SA(0, 0), cA, voffA); PG8_STAGE(PG8_SA(0, 1), cA + hstep, voffA);
        if (wr == 1) PG8_BAR;
        PG8_WAIT_V(2); PG8_BAR;
        PG8_STAGE(PG8_SB(1, 0), cB + kstep, voffB); PG8_STAGE(PG8_SA(1, 0), cA + kstep, voffA); PG8_STAGE(PG8_SB(1, 1), cB + hstep + kstep, voffB);
        PG8_WAIT_V(6); PG8_BAR;
    } else {
        PG8_STAGE(PG8_SB(0, 0), cB, voffB); PG8_STAGE(PG8_SA(0, 0), cA, voffA); PG8_STAGE(PG8_SB(0, 1), cB + hstep, voffB); PG8_STAGE(PG8_SA(0, 1), cA + hstep, voffA);
        if (wr == 1) PG8_BAR;
        PG8_WAIT_V(4); PG8_BAR;
        PG8_STAGE(PG8_SB(1, 0), cB + kstep, voffB); PG8_STAGE(PG8_SA(1, 0), cA + kstep, voffA); PG8_STAGE(PG8_SB(1, 1), cB + hstep + kstep, voffB);
        PG8_WAIT_V(6); PG8_BAR;
    }
    for (;;) {
        const bool has_next = S.next(ui + 1, nxt);
        const char* nA = has_next ? (const char*)g.A + (size_t)nxt.pm * tstep : cA; const char* nB = has_next ? (const char*)g.Bt + (size_t)nxt.pn * tstep : cB;
        for (int t = 0; t < nt; t += 2) {
            const bool last = (t == nt - 2);
            const char* a1 = cA + (size_t)(t + 1) * kstep;
            const char* a2 = last ? nA : cA + (size_t)(t + 2) * kstep; const char* b2 = last ? nB : cB + (size_t)(t + 2) * kstep;
            const char* a3 = a2 + kstep; const char* b3 = b2 + kstep;
            if (last && has_next) S.a_ready(nxt);
            if constexpr (SP2) {
            PG8_LDB(B0, 0, 0); PG8_LDB(B1, 0, 1); PG8_SCHED; PG8_LDA(At, 0, 0); PG8_STAGE(PG8_SA(1, 1), a1 + hstep, voffA);
            PG8_WAIT_V(8); PG8_WAIT_L(0); PG8_BAR; PG8_MMA(0, 0, At, B0); PG8_MMA(0, 1, At, B1); PG8_BAR; PG8_SCHED;
            PG8_LDA(At, 0, 1); PG8_STAGE(PG8_SB(0, 0), b2, voffB); PG8_STAGE(PG8_SB(0, 1), b2 + hstep, voffB); PG8_STAGE(PG8_SA(0, 0), a2, voffA);
            PG8_WAIT_V(8); PG8_WAIT_L(0); PG8_BAR; PG8_MMA(1, 0, At, B0); PG8_MMA(1, 1, At, B1); PG8_BAR; PG8_SCHED;
            PG8_LDB(B0, 1, 0); PG8_LDB(B1, 1, 1); PG8_SCHED; PG8_LDA(At, 1, 0); PG8_STAGE(PG8_SA(0, 1), a2 + hstep, voffA);
            PG8_WAIT_V(8); PG8_WAIT_L(0); PG8_BAR; PG8_MMA(0, 0, At, B0); PG8_MMA(0, 1, At, B1); PG8_BAR; PG8_SCHED;
            PG8_LDA(At, 1, 1); PG8_STAGE(PG8_SB(1, 0), b3, voffB); PG8_STAGE(PG8_SB(1, 1), b3 + hstep, voffB); PG8_STAGE(PG8_SA(1, 0), a3, voffA);
            PG8_WAIT_V(8); PG8_WAIT_L(0); PG8_BAR; PG8_MMA(1, 0, At, B0); PG8_MMA(1, 1, At, B1); PG8_BAR; PG8_SCHED;
            } else {
            PG8_LDB(B0, 0, 0); PG8_SCHED; PG8_LDA(At, 0, 0); PG8_STAGE(PG8_SA(1, 1), a1 + hstep, voffA);
            PG8_WAIT_L(8); PG8_BAR; PG8_WAIT_L(0); PG8_MMA(0, 0, At, B0); PG8_BAR; PG8_SCHED;
            PG8_LDB(B1, 0, 1); PG8_STAGE(PG8_SB(0, 0), b2, voffB);
            PG8_BAR; PG8_WAIT_L(0); PG8_MMA(0, 1, At, B1); PG8_BAR;
            PG8_LDA(At, 0, 1); PG8_STAGE(PG8_SA(0, 0), a2, voffA);
            PG8_BAR; PG8_WAIT_L(0); PG8_MMA(1, 0, At, B0); PG8_BAR; PG8_SCHED;
            PG8_STAGE(PG8_SB(0, 1), b2 + hstep, voffB);
            PG8_WAIT_V(6); PG8_BAR; PG8_MMA(1, 1, At, B1); PG8_BAR;
            PG8_LDB(B0, 1, 0); PG8_SCHED; PG8_LDA(At, 1, 0); PG8_STAGE(PG8_SA(0, 1), a2 + hstep, voffA);
            PG8_WAIT_L(8); PG8_BAR; PG8_WAIT_L(0); PG8_MMA(0, 0, At, B0); PG8_BAR; PG8_SCHED;
            PG8_LDB(B1, 1, 1); PG8_STAGE(PG8_SB(1, 0), b3, voffB);
            PG8_BAR; PG8_WAIT_L(0); PG8_MMA(0, 1, At, B1); PG8_BAR;
            PG8_LDA(At, 1, 1); PG8_STAGE(PG8_SA(1, 0), a3, voffA);
            PG8_BAR; PG8_WAIT_L(0); PG8_MMA(1, 0, At, B0); PG8_BAR; PG8_SCHED;
            PG8_STAGE(PG8_SB(1, 1), b3 + hstep, voffB);
            PG8_WAIT_V(6); PG8_BAR; PG8_MMA(1, 1, At, B1); PG8_BAR;
            }
        }
        if constexpr (ALIGN_EPI) { if (wr == 0) PG8_BAR; }
        if constexpr (!Epi::AFTER_DRAIN) { E(acc, cur, wr, wc, fr, fq); S.done(cur); }
        if (!has_next) break;
#pragma unroll
        for (int a = 0; a < 2; ++a)
#pragma unroll
            for (int b = 0; b < 2; ++b)
#pragma unroll
                for (int m = 0; m < 4; ++m)
#pragma unroll
                    for (int n = 0; n < 2; ++n) acc[a][b][m][n] = (f32x4){0.f, 0.f, 0.f, 0.f};
        cur = nxt; cA = nA; cB = nB; ++ui;
        if constexpr (ALIGN_EPI) { if (wr == 1) PG8_BAR; }
    }
    PG8_WAIT_V(0);
    if constexpr (!ALIGN_EPI) { if (wr == 0) PG8_BAR; }
    PG8_BAR;
#undef PG8_SA
#undef PG8_SB
#undef PG8_STAGE
#undef PG8_LDA
#undef PG8_LDB
#undef PG8_MMA
#undef PG8_WAIT_V
#undef PG8_WAIT_L
#undef PG8_BAR
#undef PG8_SCHED
}
}

constexpr int NWAVES = 8;
constexpr int N_LAUNCHES = MK_N_LAUNCHES;
constexpr int DEPTH = 2, NB = 4, SEQ = 2048, DM = 2048, M = NB * SEQ, INW = 5120, DFF = 8192;
constexpr int NPHASE = 1 + 7 * DEPTH;
constexpr float NORM_EPS = 1e-6f;
constexpr float LOG2E = 1.4426950408889634f;
constexpr int C_AU = 0, C_AV = 512, C_BQ = 1024, C_BK = 1536, C_BV = 2048, C_CQ = 2560, C_CK = 3072, C_CV = 3584, C_DA = 4096, C_DG = 4608;

constexpr size_t MiB = 1u << 20;
constexpr size_t WS_RINV = 1 * MiB, WS_SSQ = 2 * MiB;
constexpr size_t WS_W = 4 * MiB, W_LAYER = 92 * MiB, W_IN = 0, W_OUT = 20 * MiB, W_FF1 = 28 * MiB, W_FF2 = 60 * MiB;
constexpr size_t WS_XB = 188 * MiB;
constexpr size_t WS_R = 220 * MiB, R_PROJ = 0, R_MIXED = 80 * MiB, R_Y1 = 112 * MiB, R_F = 0, R_Y2 = 128 * MiB;
constexpr size_t WS_END = 412 * MiB;

constexpr int RING_BYTES = 131072;
constexpr int LDS_BYTES = 147456;

#define LAS __attribute__((address_space(3)))
typedef unsigned short bf16;
typedef unsigned v4u __attribute__((ext_vector_type(4)));
typedef float f32x4 __attribute__((ext_vector_type(4)));
#define LDS_WAIT() asm volatile("s_waitcnt lgkmcnt(0)" ::: "memory")

__device__ __forceinline__ unsigned f2bf(float f) { unsigned u = __builtin_bit_cast(unsigned, f); return (u + 0x7fffu + ((u >> 16) & 1u)) >> 16; }
__device__ __forceinline__ unsigned pk2(float lo, float hi) { return f2bf(lo) | (f2bf(hi) << 16); }
__device__ __forceinline__ float bf_lo(unsigned u) { return __uint_as_float(u << 16); }
__device__ __forceinline__ float bf_hi(unsigned u) { return __uint_as_float(u & 0xffff0000u); }
__device__ __forceinline__ float bf1(bf16 h) { return __uint_as_float(((unsigned)h) << 16); }
__device__ __forceinline__ float wave_sum(float v) {
#pragma unroll
    for (int o = 1; o < 64; o <<= 1) v += __shfl_xor(v, o);
    return v;
}
__device__ __forceinline__ float gelu_tanh(float x) { const float z = 0.7978845608028654f * (x + 0.044715f * x * x * x); return x / (1.f + __expf(-2.f * z)); }
__device__ __forceinline__ float sigmoidf_(float x) { return 1.f / (1.f + __expf(-x)); }

struct Args { const float* in[16]; float* out; unsigned char* ws; int ph_lo, ph_hi; };

struct Ctx {
    int tid, lane, wave, G, blk;
    LAS unsigned char* lds;
};

__device__ __forceinline__ void p0_transpose_item(const float* W, int K, int N, bf16* WT, const float* gk, LAS float* scr, int item, int lane) {
    const int nblk = N / 32, kb = item / nblk, nb = item % nblk, k0 = 64 * kb, n0 = 32 * nb;
#pragma unroll 8
    for (int i = 0; i < 32; ++i) { const int kk = 2 * i + (lane >> 5); const float sc = gk ? gk[k0 + kk] : 1.f; scr[kk * 33 + (lane & 31)] = W[(size_t)(k0 + kk) * N + n0 + (lane & 31)] * sc; }
    LDS_WAIT(); asm volatile("" ::: "memory");
    const int c = lane & 7;
#pragma unroll
    for (int j = 0; j < 4; ++j) { const int n = (lane >> 3) + 8 * j; const LAS float* s = scr + (8 * c) * 33 + n;
        v4u o; o.x = pk2(s[0 * 33], s[1 * 33]); o.y = pk2(s[2 * 33], s[3 * 33]); o.z = pk2(s[4 * 33], s[5 * 33]); o.w = pk2(s[6 * 33], s[7 * 33]);
        *(v4u*)(WT + (size_t)(n0 + n) * K + k0 + 8 * c) = o; }
    LDS_WAIT(); asm volatile("" ::: "memory");
}

__device__ __forceinline__ void p0_prologue(const Ctx& C, const Args& a) {
    LAS float* scr = (LAS float*)(C.lds + C.wave * 16384);
    const int gw = C.blk * NWAVES + C.wave, NGW = C.G * NWAVES;
    constexpr int I_IN = (DM / 64) * (INW / 32), I_OUT = (DM / 64) * (DM / 32), I_F1 = (DM / 64) * (DFF / 32), I_F2 = (DFF / 64) * (DM / 32);
    constexpr int PER_LAYER = I_IN + I_OUT + I_F1 + I_F2;
    for (int it = gw; it < DEPTH * PER_LAYER; it += NGW) {
        const int li = it / PER_LAYER; int r = it % PER_LAYER;
        unsigned char* wb = a.ws + WS_W + (size_t)li * W_LAYER;
        if (r < I_IN) { p0_transpose_item(a.in[3] + (size_t)li * DM * INW, DM, INW, (bf16*)(wb + W_IN), a.in[1] + li * DM, scr, r, C.lane); continue; } r -= I_IN;
        if (r < I_OUT) { p0_transpose_item(a.in[11] + (size_t)li * DM * DM, DM, DM, (bf16*)(wb + W_OUT), nullptr, scr, r, C.lane); continue; } r -= I_OUT;
        if (r < I_F1) { p0_transpose_item(a.in[14] + (size_t)li * DM * DFF, DM, DFF, (bf16*)(wb + W_FF1), a.in[12] + li * DM, scr, r, C.lane); continue; } r -= I_F1;
        p0_transpose_item(a.in[15] + (size_t)li * DFF * DM, DFF, DM, (bf16*)(wb + W_FF2), nullptr, scr, r, C.lane);
    }
    if (C.blk == 0 && C.tid < 64 * DEPTH) ((unsigned*)a.ws)[C.tid] = 0u;
    const float* x = a.in[0]; bf16* xb = (bf16*)(a.ws + WS_XB); float* rinv = (float*)(a.ws + WS_RINV);
    for (int m = gw; m < M; m += NGW) {
        const f32x4* xr = (const f32x4*)(x + (size_t)m * DM) + C.lane; unsigned long long* o8 = (unsigned long long*)(xb + (size_t)m * DM) + C.lane; float s = 0.f;
#pragma unroll
        for (int j = 0; j < 8; ++j) { const f32x4 v = xr[64 * j]; s += (v.x * v.x + v.y * v.y) + (v.z * v.z + v.w * v.w);
            o8[64 * j] = (unsigned long long)pk2(v.x, v.y) | ((unsigned long long)pk2(v.z, v.w) << 32); }
        s = wave_sum(s);
        if (C.lane == 0) rinv[m] = 1.f / sqrtf(s * (1.f / DM) + NORM_EPS);
    }
}

__device__ __forceinline__ void resid_phase(const Ctx& C, const Args& a, const float* xold, const float* y, const float* g) {
    const int gw = C.blk * NWAVES + C.wave, NGW = C.G * NWAVES;
    const float* ssq = (const float*)(a.ws + WS_SSQ); bf16* xb = (bf16*)(a.ws + WS_XB); float* rinv = (float*)(a.ws + WS_RINV);
    for (int m = gw; m < M; m += NGW) {
        float p = (C.lane < 32) ? ssq[(size_t)m * 32 + C.lane] : 0.f; p = wave_sum(p);
        const float rs = 1.f / sqrtf(p * (1.f / DM) + NORM_EPS);
        const f32x4* xr = (const f32x4*)(xold + (size_t)m * DM) + C.lane; const f32x4* yr = (const f32x4*)(y + (size_t)m * DM) + C.lane; const f32x4* gr = (const f32x4*)g + C.lane;
        f32x4* orow = (f32x4*)(a.out + (size_t)m * DM) + C.lane; unsigned long long* o8 = (unsigned long long*)(xb + (size_t)m * DM) + C.lane; float s = 0.f;
#pragma unroll
        for (int j = 0; j < 8; ++j) { const f32x4 xv = xr[64 * j], yv = yr[64 * j], gv = gr[64 * j]; const f32x4 v = xv + yv * rs * gv;
            s += (v.x * v.x + v.y * v.y) + (v.z * v.z + v.w * v.w); orow[64 * j] = v;
            o8[64 * j] = (unsigned long long)pk2(v.x, v.y) | ((unsigned long long)pk2(v.z, v.w) << 32); }
        s = wave_sum(s);
        if (C.lane == 0) rinv[m] = 1.f / sqrtf(s * (1.f / DM) + NORM_EPS);
    }
}

__device__ __forceinline__ void att_key(const bf16* kp, const bf16* vp, float bias2, const float (&q)[64], float& m, float& l, float (&o)[64]) {
    float s = 0.f;
#pragma unroll
    for (int c = 0; c < 8; ++c) { const uint4 kk = ((const uint4*)kp)[c];
        s += q[8 * c + 0] * bf_lo(kk.x) + q[8 * c + 1] * bf_hi(kk.x) + q[8 * c + 2] * bf_lo(kk.y) + q[8 * c + 3] * bf_hi(kk.y)
           + q[8 * c + 4] * bf_lo(kk.z) + q[8 * c + 5] * bf_hi(kk.z) + q[8 * c + 6] * bf_lo(kk.w) + q[8 * c + 7] * bf_hi(kk.w); }
    s += bias2;
    if (s > m) { const float al = __builtin_amdgcn_exp2f(m - s); l *= al;
#pragma unroll
        for (int d = 0; d < 64; ++d) o[d] *= al;
        m = s; }
    const float p = __builtin_amdgcn_exp2f(s - m);
    l += p;
#pragma unroll
    for (int c = 0; c < 8; ++c) { const uint4 vv = ((const uint4*)vp)[c];
        o[8 * c + 0] += p * bf_lo(vv.x); o[8 * c + 1] += p * bf_hi(vv.x); o[8 * c + 2] += p * bf_lo(vv.y); o[8 * c + 3] += p * bf_hi(vv.y);
        o[8 * c + 4] += p * bf_lo(vv.z); o[8 * c + 5] += p * bf_hi(vv.z); o[8 * c + 6] += p * bf_lo(vv.w); o[8 * c + 7] += p * bf_hi(vv.w); }
}
__device__ __forceinline__ void load_q64(const bf16* qp, float sc, float (&q)[64]) {
#pragma unroll
    for (int c = 0; c < 8; ++c) { const uint4 qq = ((const uint4*)qp)[c];
        q[8 * c + 0] = sc * bf_lo(qq.x); q[8 * c + 1] = sc * bf_hi(qq.x); q[8 * c + 2] = sc * bf_lo(qq.y); q[8 * c + 3] = sc * bf_hi(qq.y);
        q[8 * c + 4] = sc * bf_lo(qq.z); q[8 * c + 5] = sc * bf_hi(qq.z); q[8 * c + 6] = sc * bf_lo(qq.w); q[8 * c + 7] = sc * bf_hi(qq.w); }
}
__device__ __forceinline__ void store64_bf16(bf16* op, const float (&o)[64]) {
#pragma unroll
    for (int c = 0; c < 8; ++c) { v4u w; w.x = pk2(o[8 * c + 0], o[8 * c + 1]); w.y = pk2(o[8 * c + 2], o[8 * c + 3]); w.z = pk2(o[8 * c + 4], o[8 * c + 5]); w.w = pk2(o[8 * c + 6], o[8 * c + 7]);
        ((v4u*)op)[c] = w; }
}

typedef float f32x16 __attribute__((ext_vector_type(16)));
typedef short v4i16_t __attribute__((ext_vector_type(4)));
typedef short bf16x8_t __attribute__((ext_vector_type(8)));
constexpr int D_KRS = 272, D_VRS = 320, D_KB = 64 * D_KRS, D_VB = 64 * D_VRS;
constexpr int D_K0 = 0, D_K1 = D_KB, D_V0 = 2 * D_KB, D_V1 = 2 * D_KB + D_VB;
__device__ __forceinline__ unsigned cvtpk(float lo, float hi) { unsigned r; asm volatile("v_cvt_pk_bf16_f32 %0, %1, %2" : "=v"(r) : "v"(lo), "v"(hi)); return r; }
__device__ __forceinline__ v4i16_t tr_read(LAS unsigned char* p) { return __builtin_amdgcn_ds_read_tr16_b64_v4i16((LAS v4i16_t*)p); }

__device__ __forceinline__ void diff_unit(const Ctx& C, const Args& a, int li, int bh, int qblk, float lam, float lam_init) {
    const bf16* proj = (const bf16*)(a.ws + WS_R + R_PROJ); bf16* mixed = (bf16*)(a.ws + WS_R + R_MIXED);
    const int b = bh >> 2, h = bh & 3;
    const int lane = C.lane, r32 = lane & 31, hi = lane >> 5, map = C.wave >> 2, sl = C.wave & 3;
    const int qw0 = qblk * 128 + 32 * sl, qpos = qw0 + r32;
    const bf16* kvbase = proj + (size_t)b * SEQ * INW;
    LAS unsigned char* lds = C.lds;
    bf16x8_t qf[4];
    { const bf16* qp = kvbase + (size_t)qpos * INW + C_BQ + h * 128 + map * 64 + 8 * hi;
#pragma unroll
      for (int d0 = 0; d0 < 4; ++d0) qf[d0] = *(const bf16x8_t*)(qp + 16 * d0); }
    const float slope2 = exp2f(-8.f * (float)(3 * h + 1) / 12.f) * LOG2E; const float C2 = 0.125f * LOG2E;
    f32x16 O[4];
#pragma unroll
    for (int i = 0; i < 4; ++i)
#pragma unroll
        for (int r = 0; r < 16; ++r) O[i][r] = 0.f;
    float m = -INFINITY, l = 0.f;
    const int NT = 2 * qblk + 2;
    v4u kreg[2], vreg[2];
#define D_GLOAD(t) do { _Pragma("unroll") for (int i_ = 0; i_ < 2; ++i_) { const int id_ = C.tid + 512 * i_, row_ = id_ >> 4, ch_ = id_ & 15; \
        const bf16* rp_ = kvbase + (size_t)((t) * 64 + row_) * INW + h * 128 + ch_ * 8; kreg[i_] = *(const v4u*)(rp_ + C_BK); vreg[i_] = *(const v4u*)(rp_ + C_BV); } } while (0)
#define D_LSTORE(buf) do { _Pragma("unroll") for (int i_ = 0; i_ < 2; ++i_) { const int id_ = C.tid + 512 * i_, row_ = id_ >> 4, ch_ = id_ & 15; \
        *(LAS v4u*)(lds + ((buf) ? D_K1 : D_K0) + row_ * D_KRS + ch_ * 16) = kreg[i_]; *(LAS v4u*)(lds + ((buf) ? D_V1 : D_V0) + row_ * D_VRS + ch_ * 16) = vreg[i_]; } } while (0)
    D_GLOAD(0); D_LSTORE(0);
    __syncthreads();
    const int koff = r32 * D_KRS + map * 128 + hi * 16;
    const int voff = (4 * hi + ((lane & 15) >> 2)) * D_VRS + (16 * ((lane >> 4) & 1) + 4 * (lane & 3)) * 2;
    for (int t = 0; t < NT; ++t) {
        const int buf = t & 1;
        if (t + 1 < NT) D_GLOAD(t + 1);
        const int k0 = t * 64;
        if (k0 <= qw0 + 31) {
            LAS unsigned char* kb_ = lds + (buf ? D_K1 : D_K0) + koff; LAS unsigned char* vb_ = lds + (buf ? D_V1 : D_V0) + voff;
            f32x16 p0, p1;
#pragma unroll
            for (int r = 0; r < 16; ++r) { p0[r] = 0.f; p1[r] = 0.f; }
#pragma unroll
            for (int d0 = 0; d0 < 4; ++d0) { const bf16x8_t kf0 = *(LAS bf16x8_t*)(kb_ + d0 * 32), kf1 = *(LAS bf16x8_t*)(kb_ + 32 * D_KRS + d0 * 32);
                p0 = __builtin_amdgcn_mfma_f32_32x32x16_bf16(kf0, qf[d0], p0, 0, 0, 0); p1 = __builtin_amdgcn_mfma_f32_32x32x16_bf16(kf1, qf[d0], p1, 0, 0, 0); }
            const float bb = slope2 * (float)(k0 + 4 * hi - qpos);
#pragma unroll
            for (int r = 0; r < 16; ++r) { const int c = (r & 3) + 8 * (r >> 2); p0[r] = fmaf(p0[r], C2, bb + slope2 * (float)c); p1[r] = fmaf(p1[r], C2, bb + slope2 * (float)(c + 32)); }
            if (k0 + 63 > qw0) {
#pragma unroll
                for (int r = 0; r < 16; ++r) { const int kp = k0 + 4 * hi + (r & 3) + 8 * (r >> 2); if (kp > qpos) p0[r] = -INFINITY; if (kp + 32 > qpos) p1[r] = -INFINITY; }
            }
            float tmax = fmaxf(p0[0], p1[0]);
#pragma unroll
            for (int r = 1; r < 16; ++r) tmax = fmaxf(tmax, fmaxf(p0[r], p1[r]));
            tmax = fmaxf(tmax, __shfl_xor(tmax, 32));
            const float mn = fmaxf(m, tmax), al = __builtin_amdgcn_exp2f(m - mn); m = mn;
            float rs = 0.f;
#pragma unroll
            for (int r = 0; r < 16; ++r) { p0[r] = __builtin_amdgcn_exp2f(p0[r] - mn); p1[r] = __builtin_amdgcn_exp2f(p1[r] - mn); rs += p0[r] + p1[r]; }
            l = l * al + rs;
#pragma unroll
            for (int i = 0; i < 4; ++i)
#pragma unroll
                for (int r = 0; r < 16; ++r) O[i][r] *= al;
            bf16x8_t pb[4];
            { v4u w;
              w.x = cvtpk(p0[0], p0[1]); w.y = cvtpk(p0[2], p0[3]); w.z = cvtpk(p0[4], p0[5]); w.w = cvtpk(p0[6], p0[7]); pb[0] = __builtin_bit_cast(bf16x8_t, w);
              w.x = cvtpk(p0[8], p0[9]); w.y = cvtpk(p0[10], p0[11]); w.z = cvtpk(p0[12], p0[13]); w.w = cvtpk(p0[14], p0[15]); pb[1] = __builtin_bit_cast(bf16x8_t, w);
              w.x = cvtpk(p1[0], p1[1]); w.y = cvtpk(p1[2], p1[3]); w.z = cvtpk(p1[4], p1[5]); w.w = cvtpk(p1[6], p1[7]); pb[2] = __builtin_bit_cast(bf16x8_t, w);
              w.x = cvtpk(p1[8], p1[9]); w.y = cvtpk(p1[10], p1[11]); w.z = cvtpk(p1[12], p1[13]); w.w = cvtpk(p1[14], p1[15]); pb[3] = __builtin_bit_cast(bf16x8_t, w); }
#pragma unroll
            for (int ks = 0; ks < 4; ++ks)
#pragma unroll
                for (int i = 0; i < 4; ++i) { LAS unsigned char* vp = vb_ + (16 * ks) * D_VRS + i * 64;
                    const v4i16_t t0 = tr_read(vp), t1 = tr_read(vp + 8 * D_VRS);
                    const bf16x8_t vf = (bf16x8_t){t0[0], t0[1], t0[2], t0[3], t1[0], t1[1], t1[2], t1[3]};
                    O[i] = __builtin_amdgcn_mfma_f32_32x32x16_bf16(vf, pb[ks], O[i], 0, 0, 0); }
        }
        if (t + 1 < NT) D_LSTORE(buf ^ 1);
        __syncthreads();
    }
#undef D_GLOAD
#undef D_LSTORE
    l += __shfl_xor(l, 32);
    { const float inv = 1.f / l;
#pragma unroll
      for (int i = 0; i < 4; ++i)
#pragma unroll
          for (int r = 0; r < 16; ++r) O[i][r] *= inv; }
    LAS float* X = (LAS float*)lds;
    if (map == 1) {
#pragma unroll
        for (int i = 0; i < 4; ++i)
#pragma unroll
            for (int r = 0; r < 16; ++r) X[(sl * 64 + i * 16 + r) * 64 + lane] = O[i][r];
    }
    __syncthreads();
    if (map == 0) {
        float ss = 0.f;
#pragma unroll
        for (int i = 0; i < 4; ++i)
#pragma unroll
            for (int r = 0; r < 16; ++r) { const float o = O[i][r] - lam * X[(sl * 64 + i * 16 + r) * 64 + lane]; O[i][r] = o; ss += o * o; }
        ss += __shfl_xor(ss, 32);
        const float rr = (1.f - lam_init) / sqrtf(ss * (1.f / 128.f) + NORM_EPS);
        const float* sg = a.in[7] + li * 128;
        bf16* orow = mixed + ((size_t)b * SEQ + qpos) * DM + 512 + h * 128;
#pragma unroll
        for (int i = 0; i < 4; ++i)
#pragma unroll
            for (int g = 0; g < 4; ++g) { const int d = i * 32 + 8 * g + 4 * hi; const f32x4 gv = *(const f32x4*)(sg + d);
                uint2 wv; wv.x = pk2(O[i][4 * g] * rr * gv.x, O[i][4 * g + 1] * rr * gv.y); wv.y = pk2(O[i][4 * g + 2] * rr * gv.z, O[i][4 * g + 3] * rr * gv.w);
                *(uint2*)(orow + d) = wv; }
    }
    __syncthreads();
}

constexpr int DL_VRS = 192, DL_VST = 32 * DL_VRS;
constexpr size_t DP_O = 0, DP_M = 32 * MiB, DP_L = 33 * MiB;
__device__ __forceinline__ void dil_tile(const Ctx& C, const bf16* kvb, int dil, int rc, int J0, float slope2, LAS unsigned char* vst, float& m, float& l, f32x16 (&O)[2]) {
    const int lane = C.lane, r32 = lane & 31, hi = lane >> 5;
    const int J = J0 + r32; const size_t t = (size_t)dil * J + rc;
    bf16x8_t qf[4];
#pragma unroll
    for (int d0 = 0; d0 < 4; ++d0) qf[d0] = *(const bf16x8_t*)(kvb + t * INW + C_CQ + 16 * d0 + 8 * hi);
    m = -INFINITY; l = 0.f;
#pragma unroll
    for (int i = 0; i < 2; ++i)
#pragma unroll
        for (int r = 0; r < 16; ++r) O[i][r] = 0.f;
    const int c_hi = J0 >> 5; const int c_lo = (c_hi - 4 < 0) ? 0 : c_hi - 4;
    const float sd2 = slope2 * (float)dil, C2 = 0.125f * LOG2E;
    const int voff = (4 * hi + ((lane & 15) >> 2)) * DL_VRS + (16 * ((lane >> 4) & 1) + 4 * (lane & 3)) * 2;
    bf16x8_t kf[4]; v4u vr[4];
#define DL_LOADKV(c) do { const bf16* kp_ = kvb + ((size_t)dil * (32 * (c) + r32) + rc) * INW + C_CK + 8 * hi; \
        _Pragma("unroll") for (int d0 = 0; d0 < 4; ++d0) kf[d0] = *(const bf16x8_t*)(kp_ + 16 * d0); \
        _Pragma("unroll") for (int i_ = 0; i_ < 4; ++i_) { const int p_ = lane + 64 * i_; vr[i_] = *(const v4u*)(kvb + ((size_t)dil * (32 * (c) + (p_ >> 3)) + rc) * INW + C_CV + (p_ & 7) * 8); } } while (0)
    DL_LOADKV(c_lo);
    for (int c = c_lo; c <= c_hi; ++c) {
        bf16x8_t kc[4]; v4u vc[4];
#pragma unroll
        for (int i = 0; i < 4; ++i) { kc[i] = kf[i]; vc[i] = vr[i]; }
        if (c < c_hi) DL_LOADKV(c + 1);
#pragma unroll
        for (int i = 0; i < 4; ++i) { const int p_ = lane + 64 * i; *(LAS v4u*)(vst + (p_ >> 3) * DL_VRS + (p_ & 7) * 16) = vc[i]; }
        f32x16 p;
#pragma unroll
        for (int r = 0; r < 16; ++r) p[r] = 0.f;
#pragma unroll
        for (int d0 = 0; d0 < 4; ++d0) p = __builtin_amdgcn_mfma_f32_32x32x16_bf16(kc[d0], qf[d0], p, 0, 0, 0);
        const int jb = 32 * c + 4 * hi;
        const float bb = sd2 * (float)(jb - J);
#pragma unroll
        for (int r = 0; r < 16; ++r) p[r] = fmaf(p[r], C2, bb + sd2 * (float)((r & 3) + 8 * (r >> 2)));
        if (c == c_hi) {
#pragma unroll
            for (int r = 0; r < 16; ++r) if (jb + (r & 3) + 8 * (r >> 2) > J) p[r] = -INFINITY;
        }
        if (c == c_hi - 4) {
#pragma unroll
            for (int r = 0; r < 16; ++r) if (jb + (r & 3) + 8 * (r >> 2) < J - 128) p[r] = -INFINITY;
        }
        float tmax = p[0];
#pragma unroll
        for (int r = 1; r < 16; ++r) tmax = fmaxf(tmax, p[r]);
        tmax = fmaxf(tmax, __shfl_xor(tmax, 32));
        const float mn = fmaxf(m, tmax), al = __builtin_amdgcn_exp2f(m - mn); m = mn;
        float rs = 0.f;
#pragma unroll
        for (int r = 0; r < 16; ++r) { p[r] = __builtin_amdgcn_exp2f(p[r] - mn); rs += p[r]; }
        l = l * al + rs;
#pragma unroll
        for (int i = 0; i < 2; ++i)
#pragma unroll
            for (int r = 0; r < 16; ++r) O[i][r] *= al;
        bf16x8_t pb[2];
        { v4u w;
          w.x = cvtpk(p[0], p[1]); w.y = cvtpk(p[2], p[3]); w.z = cvtpk(p[4], p[5]); w.w = cvtpk(p[6], p[7]); pb[0] = __builtin_bit_cast(bf16x8_t, w);
          w.x = cvtpk(p[8], p[9]); w.y = cvtpk(p[10], p[11]); w.z = cvtpk(p[12], p[13]); w.w = cvtpk(p[14], p[15]); pb[1] = __builtin_bit_cast(bf16x8_t, w); }
        asm volatile("s_waitcnt lgkmcnt(0)" ::: "memory");
#pragma unroll
        for (int ks = 0; ks < 2; ++ks)
#pragma unroll
            for (int i = 0; i < 2; ++i) { LAS unsigned char* vp = vst + voff + (16 * ks) * DL_VRS + i * 64;
                const v4i16_t t0 = tr_read(vp), t1 = tr_read(vp + 8 * DL_VRS);
                const bf16x8_t vf = (bf16x8_t){t0[0], t0[1], t0[2], t0[3], t1[0], t1[1], t1[2], t1[3]};
                O[i] = __builtin_amdgcn_mfma_f32_32x32x16_bf16(vf, pb[ks], O[i], 0, 0, 0); }
        asm volatile("s_waitcnt lgkmcnt(0)" ::: "memory");
    }
#undef DL_LOADKV
    l += __shfl_xor(l, 32);
}
__device__ __forceinline__ void dil_unit(const Ctx& C, const Args& a, int b, int h, int seg) {
    const bf16* proj = (const bf16*)(a.ws + WS_R + R_PROJ); bf16* mixed = (bf16*)(a.ws + WS_R + R_MIXED);
    unsigned char* part = a.ws + WS_R + R_Y1;
    float* PO = (float*)(part + DP_O); float* PM = (float*)(part + DP_M); float* PL = (float*)(part + DP_L);
    const bf16* kvb = proj + (size_t)b * SEQ * INW + h * 64;
    const int lane = C.lane, r32 = lane & 31, hi = lane >> 5;
    const int sidx = 3 * (h >> 1) + 1 + (h & 1);
    const float slope2 = exp2f(-8.f * (float)(sidx + 1) / 12.f) * LOG2E;
    LAS unsigned char* vst = C.lds + C.wave * DL_VST;
    const size_t qbase = (size_t)(b * 8 + h) * SEQ;
    float m, l; f32x16 O[2];
#pragma unroll 1
    for (int i = 0; i < 4; ++i) { const int tl = C.wave * 4 + i, pat = tl >> 4, k = tl & 15;
        const int dil = pat ? 4 : 1, rc = pat ? (k >> 2) : 0, J0 = pat ? (128 * seg + 32 * (k & 3)) : (512 * seg + 32 * k);
        dil_tile(C, kvb, dil, rc, J0, slope2, vst, m, l, O);
        const size_t idx = (size_t)pat * 65536 + qbase + (size_t)dil * (J0 + r32) + rc;
#pragma unroll
        for (int ii = 0; ii < 2; ++ii)
#pragma unroll
            for (int g = 0; g < 4; ++g) *(f32x4*)(PO + idx * 64 + ii * 32 + 8 * g + 4 * hi) = (f32x4){O[ii][4 * g], O[ii][4 * g + 1], O[ii][4 * g + 2], O[ii][4 * g + 3]};
        if (hi == 0) { PM[idx] = m; PL[idx] = l; } }
    __syncthreads();
#pragma unroll 1
    for (int i = 0; i < 2; ++i) { const int rc = C.wave * 2 + i, J0 = 32 * seg;
        dil_tile(C, kvb, 16, rc, J0, slope2, vst, m, l, O);
        const size_t t = (size_t)16 * (J0 + r32) + rc, i1 = qbase + t, i2 = 65536 + qbase + t;
        const float m1 = PM[i1], l1 = PL[i1], m2 = PM[i2], l2 = PL[i2];
        const float mx = fmaxf(m, fmaxf(m1, m2));
        const float w3 = __builtin_amdgcn_exp2f(m - mx), w1 = __builtin_amdgcn_exp2f(m1 - mx), w2 = __builtin_amdgcn_exp2f(m2 - mx);
        const float inv = 1.f / (w3 * l + w1 * l1 + w2 * l2);
        bf16* orow = mixed + ((size_t)b * SEQ + t) * DM + 1024 + h * 64;
#pragma unroll
        for (int ii = 0; ii < 2; ++ii)
#pragma unroll
            for (int g = 0; g < 4; ++g) { const int d = ii * 32 + 8 * g + 4 * hi; const f32x4 o1 = *(const f32x4*)(PO + i1 * 64 + d), o2 = *(const f32x4*)(PO + i2 * 64 + d);
                const float v0 = (w3 * O[ii][4 * g] + w1 * o1.x + w2 * o2.x) * inv, v1 = (w3 * O[ii][4 * g + 1] + w1 * o1.y + w2 * o2.y) * inv;
                const float v2 = (w3 * O[ii][4 * g + 2] + w1 * o1.z + w2 * o2.z) * inv, v3 = (w3 * O[ii][4 * g + 3] + w1 * o1.w + w2 * o2.w) * inv;
                uint2 wv; wv.x = pk2(v0, v1); wv.y = pk2(v2, v3); *(uint2*)(orow + d) = wv; } }
    __syncthreads();
}

constexpr int G_VRS = 1088;
__device__ __forceinline__ void gmlp_unit(const Ctx& C, const Args& a, int li, int unit) {
    const bf16* proj = (const bf16*)(a.ws + WS_R + R_PROJ); bf16* mixed = (bf16*)(a.ws + WS_R + R_MIXED);
    const size_t row0 = (size_t)unit * 128;
    LAS unsigned char* vn = C.lds;
    const int lane = C.lane, r32 = lane & 31, hi = lane >> 5;
#pragma unroll 4
    for (int tt = 0; tt < 16; ++tt) { const int t = C.wave * 16 + tt;
        const v4u vv = *(const v4u*)(proj + (row0 + t) * INW + C_AV + lane * 8);
        float v[8] = {bf_lo(vv.x), bf_hi(vv.x), bf_lo(vv.y), bf_hi(vv.y), bf_lo(vv.z), bf_hi(vv.z), bf_lo(vv.w), bf_hi(vv.w)}; float s = 0.f;
#pragma unroll
        for (int e = 0; e < 8; ++e) { v[e] = gelu_tanh(v[e]); s += v[e]; }
        const float mean = wave_sum(s) * (1.f / 512.f); float s2 = 0.f;
#pragma unroll
        for (int e = 0; e < 8; ++e) { v[e] -= mean; s2 += v[e] * v[e]; }
        const float rstd = 1.f / sqrtf(wave_sum(s2) * (1.f / 512.f) + NORM_EPS);
        v4u w; w.x = pk2(v[0] * rstd, v[1] * rstd); w.y = pk2(v[2] * rstd, v[3] * rstd); w.z = pk2(v[4] * rstd, v[5] * rstd); w.w = pk2(v[6] * rstd, v[7] * rstd);
        *(LAS v4u*)(vn + t * G_VRS + lane * 16) = w; }
    __syncthreads();
    const int g = C.wave;
    const float* W = a.in[4] + ((size_t)li * 8 + g) * 128 * 128; const float* bs = a.in[5] + ((size_t)li * 8 + g) * 128;
    const int aoff = (8 * hi + ((lane & 15) >> 2)) * G_VRS + (g * 64 + 16 * ((lane >> 4) & 1) + 4 * (lane & 3)) * 2;
#pragma unroll 1
    for (int tb = 0; tb < 4; ++tb) {
        f32x16 acc[2];
#pragma unroll
        for (int i = 0; i < 2; ++i)
#pragma unroll
            for (int r = 0; r < 16; ++r) acc[i][r] = 0.f;
        const int t = tb * 32 + r32;
        const float* wrow = W + t * 128 + 8 * hi;
#pragma unroll 2
        for (int ks = 0; ks <= 2 * tb + 1; ++ks) { const int s0 = 16 * ks, sb = s0 + 8 * hi;
            const f32x4 w0 = *(const f32x4*)(wrow + s0), w1 = *(const f32x4*)(wrow + s0 + 4);
            float wv[8] = {w0.x, w0.y, w0.z, w0.w, w1.x, w1.y, w1.z, w1.w};
#pragma unroll
            for (int j = 0; j < 8; ++j) if (sb + j > t) wv[j] = 0.f;
            v4u wp; wp.x = cvtpk(wv[0], wv[1]); wp.y = cvtpk(wv[2], wv[3]); wp.z = cvtpk(wv[4], wv[5]); wp.w = cvtpk(wv[6], wv[7]);
            const bf16x8_t bfrag = __builtin_bit_cast(bf16x8_t, wp);
#pragma unroll
            for (int i = 0; i < 2; ++i) { LAS unsigned char* vp = vn + aoff + s0 * G_VRS + i * 64;
                const v4i16_t t0 = tr_read(vp), t1 = tr_read(vp + 4 * G_VRS);
                const bf16x8_t af = (bf16x8_t){t0[0], t0[1], t0[2], t0[3], t1[0], t1[1], t1[2], t1[3]};
                acc[i] = __builtin_amdgcn_mfma_f32_32x32x16_bf16(af, bfrag, acc[i], 0, 0, 0); } }
        const float bt = bs[t];
        const bf16* urow = proj + (row0 + t) * INW + C_AU + g * 64; bf16* orow = mixed + (row0 + t) * DM + g * 64;
#pragma unroll
        for (int i = 0; i < 2; ++i)
#pragma unroll
            for (int gq = 0; gq < 4; ++gq) { const int d = i * 32 + 8 * gq + 4 * hi; const uint2 uu = *(const uint2*)(urow + d);
                const float u0 = gelu_tanh(bf_lo(uu.x)), u1 = gelu_tanh(bf_hi(uu.x)), u2 = gelu_tanh(bf_lo(uu.y)), u3 = gelu_tanh(bf_hi(uu.y));
                uint2 wv2; wv2.x = pk2(u0 * (acc[i][4 * gq] + bt), u1 * (acc[i][4 * gq + 1] + bt)); wv2.y = pk2(u2 * (acc[i][4 * gq + 2] + bt), u3 * (acc[i][4 * gq + 3] + bt));
                *(uint2*)(orow + d) = wv2; }
    }
    __syncthreads();
}

__device__ __forceinline__ void conv_unit(const Ctx& C, const Args& a, int li, int unit) {
    const bf16* proj = (const bf16*)(a.ws + WS_R + R_PROJ); bf16* mixed = (bf16*)(a.ws + WS_R + R_MIXED);
    const int b = unit >> 6, t0 = (unit & 63) * 32, c = C.tid;
    LAS float* hs = (LAS float*)C.lds;
    const float* cw = a.in[8] + (size_t)li * 31 * 512;
#pragma unroll
    for (int k = 0; k < 8; ++k) { const int i = C.wave + 8 * k; const int s = t0 - 30 + i;
        if (i < 62) { float hv[8];
#pragma unroll
            for (int e = 0; e < 8; ++e) hv[e] = 0.f;
            if (s >= 0) { const bf16* pr = proj + ((size_t)b * SEQ + s) * INW + C.lane * 8; const v4u av = *(const v4u*)(pr + C_DA), gv = *(const v4u*)(pr + C_DG);
                hv[0] = bf_lo(av.x) * sigmoidf_(bf_lo(gv.x)); hv[1] = bf_hi(av.x) * sigmoidf_(bf_hi(gv.x)); hv[2] = bf_lo(av.y) * sigmoidf_(bf_lo(gv.y)); hv[3] = bf_hi(av.y) * sigmoidf_(bf_hi(gv.y));
                hv[4] = bf_lo(av.z) * sigmoidf_(bf_lo(gv.z)); hv[5] = bf_hi(av.z) * sigmoidf_(bf_hi(gv.z)); hv[6] = bf_lo(av.w) * sigmoidf_(bf_lo(gv.w)); hv[7] = bf_hi(av.w) * sigmoidf_(bf_hi(gv.w)); }
            *(LAS f32x4*)(hs + i * 512 + C.lane * 8) = (f32x4){hv[0], hv[1], hv[2], hv[3]}; *(LAS f32x4*)(hs + i * 512 + C.lane * 8 + 4) = (f32x4){hv[4], hv[5], hv[6], hv[7]}; } }
    float w[31];
#pragma unroll
    for (int k = 0; k < 31; ++k) w[k] = cw[k * 512 + c];
    const float bd = a.in[9][li * 512 + c];
    __syncthreads();
#pragma unroll 1
    for (int j = 0; j < 32; ++j) { float acc = bd;
#pragma unroll
        for (int k = 0; k < 31; ++k) acc += w[k] * hs[(j + k) * 512 + c];
        hs[j * 512 + c] = acc; }
    __syncthreads();
    const float* ng = a.in[10] + li * 512 + C.lane * 8;
#pragma unroll 1
    for (int jj = 0; jj < 4; ++jj) { const int j = C.wave * 4 + jj; float v[8]; float ss = 0.f;
#pragma unroll
        for (int e = 0; e < 8; ++e) { v[e] = hs[j * 512 + C.lane * 8 + e]; ss += v[e] * v[e]; }
        const float r = 1.f / sqrtf(wave_sum(ss) * (1.f / 512.f) + NORM_EPS);
#pragma unroll
        for (int e = 0; e < 8; ++e) { const float hn = v[e] * r * ng[e]; v[e] = hn * sigmoidf_(hn); }
        v4u wv; wv.x = pk2(v[0], v[1]); wv.y = pk2(v[2], v[3]); wv.z = pk2(v[4], v[5]); wv.w = pk2(v[6], v[7]);
        *(v4u*)(mixed + ((size_t)b * SEQ + t0 + j) * DM + 1536 + C.lane * 8) = wv; }
    __syncthreads();
}

#define LAUNDER(Cn, Cs) Ctx Cn = Cs; { int t_ = Cs.tid; asm volatile("" : "+v"(t_)); Cn.tid = t_; Cn.lane = t_ & 63; }
__device__ __forceinline__ int next_item(const Ctx& C, unsigned* ctr) {
    volatile LAS unsigned* word = (volatile LAS unsigned*)(C.lds + LDS_BYTES - 16);
    __syncthreads();
    if (C.tid == 0) *word = atomicAdd(ctr, 1u);
    __syncthreads();
    return (int)*word;
}
__device__ __forceinline__ void mixer_phase(const Ctx& C0, const Args& a, int li, int qsel = 0) {
    const float* lp = a.in[6] + li * 256;
    const float d01 = wave_sum(lp[C0.lane] * lp[64 + C0.lane]), d23 = wave_sum(lp[128 + C0.lane] * lp[192 + C0.lane]);
    const float lam_init = 0.8f - 0.6f * expf(-0.3f * (float)li);
    const float lam = expf(d01) - expf(d23) + lam_init;
    unsigned* ctr = (unsigned*)a.ws + 64 * li + 32 * qsel;
    for (;;) {
        int it = next_item(C0, ctr);
        if (it >= 64 + 256 + 128 + 256) break;
        Ctx C = C0; { int t_ = C0.tid; asm volatile("" : "+v"(t_)); C.tid = t_; C.lane = t_ & 63; }
        if (it < 64) { for (int rp_ = 0; rp_ < REP_GMLP; ++rp_) { LAUNDER(Cr, C); gmlp_unit(Cr, a, li, it); } continue; } it -= 64;
        if (it < 256) { for (int rp_ = 0; rp_ < REP_DIFF; ++rp_) { LAUNDER(Cr, C); diff_unit(Cr, a, li, it & 15, 15 - (it >> 4), lam, lam_init); } continue; } it -= 256;
        if (it < 128) { for (int rp_ = 0; rp_ < REP_DIL; ++rp_) { LAUNDER(Cr, C); dil_unit(Cr, a, it >> 5, (it >> 2) & 7, it & 3); } continue; } it -= 128;
        for (int rp_ = 0; rp_ < REP_CONV; ++rp_) { LAUNDER(Cr, C); conv_unit(Cr, a, li, it); }
    }
}

#define XB_TMO      128
#define XB_XCNT(j)  (256  + 64 * (j))
#define XB_XSUB(j)  (1280 + 64 * (j))
#define XB_XGEN(j)  (2304 + 64 * (j))
#define XB_TOP      3328
#define XB_TOPGEN   3392
#define XCD_BAR_WORDS 3456
#define XB_SPIN_CAP (1u << 18)
__device__ __forceinline__ unsigned xb_ld(unsigned* p)              { return __hip_atomic_load(p, __ATOMIC_RELAXED, __HIP_MEMORY_SCOPE_AGENT); }
__device__ __forceinline__ unsigned xb_add(unsigned* p, unsigned v) { return __hip_atomic_fetch_add(p, v, __ATOMIC_RELAXED, __HIP_MEMORY_SCOPE_AGENT); }
__device__ __forceinline__ unsigned xb_xcc_id() { return (unsigned)__builtin_amdgcn_s_getreg((3 << 11) | 20) & 0xFu; }
#define XB_SPIN(cond, bar) do { unsigned _sp = 0; while (cond) { __builtin_amdgcn_s_sleep(1); \
    if ((++_sp & 255u) == 0u) { if (xb_ld(&(bar)[XB_TMO])) break; if (_sp > XB_SPIN_CAP) { atomicAdd(&(bar)[XB_TMO], 1u); break; } } } } while (0)
struct XcdBarrier { unsigned* bar; unsigned x; volatile LAS unsigned* st; };
__device__ __forceinline__ XcdBarrier xcd_barrier_post(unsigned* bar, volatile LAS unsigned* st) {
    XcdBarrier b; b.bar = bar; b.x = xb_xcc_id(); b.st = st;
    if (threadIdx.x == 0) (void)xb_add(&bar[XB_XCNT(b.x)], 1u);
    return b;
}
__device__ __forceinline__ void xcd_barrier_complete(unsigned* bar, unsigned x, unsigned& nloc, unsigned& nx) {
    const unsigned G = gridDim.x * gridDim.y * gridDim.z;
    unsigned sum, cnt, mine, sp = 0u;
    for (;;) {
        sum = 0u; cnt = 0u; mine = 0u;
#pragma unroll
        for (unsigned j = 0; j < 16; ++j) { const unsigned c = xb_ld(&bar[XB_XCNT(j)]); sum += c; cnt += (c > 0u) ? 1u : 0u; mine = (j == x) ? c : mine; }
        if (sum == G) break;
        __builtin_amdgcn_s_sleep(1);
        if ((++sp & 255u) == 0u) { if (xb_ld(&bar[XB_TMO])) break; if (sp > XB_SPIN_CAP) { atomicAdd(&bar[XB_TMO], 1u); break; } }
    }
    nloc = mine > 0u ? mine : 1u; nx = cnt > 0u ? cnt : 1u;
}
__device__ __forceinline__ void xcd_barrier(const XcdBarrier& b) {
    asm volatile("s_waitcnt vmcnt(0)" ::: "memory");
    __syncthreads();
    if (threadIdx.x == 0) {
        unsigned* bar = b.bar;
        __builtin_amdgcn_s_waitcnt(0);
        unsigned nloc = b.st[0], nx = b.st[1];
        if (nloc == 0u) { xcd_barrier_complete(bar, b.x, nloc, nx); b.st[0] = nloc; b.st[1] = nx; }
        const unsigned old = xb_add(&bar[XB_XSUB(b.x)], 1u);
        const unsigned gen = old / nloc;
        if (old + 1u == (gen + 1u) * nloc) {
            __builtin_amdgcn_fence(__ATOMIC_RELEASE, "agent");
            asm volatile("s_waitcnt vmcnt(0)" ::: "memory");
            const unsigned og = xb_add(&bar[XB_TOP], 1u);
            const unsigned tg = og / nx;
            if (og + 1u == (tg + 1u) * nx) xb_add(&bar[XB_TOPGEN], 1u);
            else XB_SPIN(xb_ld(&bar[XB_TOPGEN]) == tg, bar);
            __builtin_amdgcn_fence(__ATOMIC_ACQUIRE, "agent");
            xb_add(&bar[XB_XGEN(b.x)], 1u);
            asm volatile("s_waitcnt vmcnt(0)" ::: "memory");
        } else {
            XB_SPIN(xb_ld(&bar[XB_XGEN(b.x)]) == gen, bar);
            __builtin_amdgcn_fence(__ATOMIC_ACQUIRE, "agent");
            asm volatile("s_waitcnt vmcnt(0)" ::: "memory");
        }
    }
    __syncthreads();
}
constexpr size_t WS_BAR = 65536;
constexpr size_t CTL_ZERO_BYTES = 131072;

__global__ void __launch_bounds__(NWAVES * 64, 2) mk_fwd(Args args) {
    extern __shared__ __attribute__((aligned(16))) unsigned char lds[];
    Ctx C; C.tid = threadIdx.x; C.lane = C.tid & 63; C.wave = __builtin_amdgcn_readfirstlane(C.tid >> 6); C.G = gridDim.x; C.blk = blockIdx.x; C.lds = (LAS unsigned char*)lds;
    const int lo = args.ph_lo, hi = args.ph_hi;
    unsigned char* ws = args.ws;
    float* rinv = (float*)(ws + WS_RINV); float* ssq = (float*)(ws + WS_SSQ);
    bf16* xb = (bf16*)(ws + WS_XB); bf16* proj = (bf16*)(ws + WS_R + R_PROJ); bf16* mixed = (bf16*)(ws + WS_R + R_MIXED);
    float* y1 = (float*)(ws + WS_R + R_Y1); float* y2 = (float*)(ws + WS_R + R_Y2); bf16* fb = (bf16*)(ws + WS_R + R_F);
#define IN(k) (lo <= (k) && (k) < hi)
    { volatile LAS unsigned* st_ = (volatile LAS unsigned*)((LAS unsigned char*)lds + LDS_BYTES - 32); if (threadIdx.x < 2) st_[threadIdx.x] = 0u; }
    __syncthreads();
    const XcdBarrier xbar = xcd_barrier_post((unsigned*)(ws + WS_BAR), (volatile LAS unsigned*)((LAS unsigned char*)lds + LDS_BYTES - 32));
#define SEAM(k) do { if (IN(k) && IN((k) + 1)) { if ((k) == 0) cg::this_grid().sync(); else xcd_barrier(xbar); } } while (0)
    if (IN(0)) { p0_prologue(C, args); }
    SEAM(0);
    for (int li = 0; li < DEPTH; ++li) {
        const int p = 1 + 7 * li;
        unsigned char* wb = ws + WS_W + (size_t)li * W_LAYER;
        asm volatile("" : "+s"(wb), "+s"(xb), "+s"(proj), "+s"(mixed), "+s"(y1), "+s"(y2), "+s"(fb), "+s"(rinv), "+s"(ssq));
        Ctx Cl; { int t_ = threadIdx.x, b_ = blockIdx.x, g_ = gridDim.x; asm volatile("" : "+v"(t_), "+s"(b_), "+s"(g_));
            Cl.tid = t_; Cl.lane = t_ & 63; Cl.wave = __builtin_amdgcn_readfirstlane(t_ >> 6); Cl.G = g_; Cl.blk = b_; Cl.lds = (LAS unsigned char*)lds; }
        if (IN(p + 0)) {
            pg8::Gemm g{xb, (const bf16*)(wb + W_IN), M, INW, DM}; pg8::StaticOrder S; S.init(M, INW, Cl.G, Cl.blk);
            pg8::EpiRowScaleBf16 E{proj, INW, rinv, 0};
            for (int rep_ = 0; rep_ < GEMM_REPS; ++rep_) { int t2_ = Cl.tid; asm volatile("" : "+v"(t2_)); pg8::gemm_phase<pg8::EpiRowScaleBf16, pg8::StaticOrder, true, true>(Cl.lds, g, S, E, t2_); }
        }
        SEAM(p + 0);
        if (IN(p + 1)) { mixer_phase(Cl, args, li);
#ifdef PROBE_MIX2
            cg::this_grid().sync(); mixer_phase(Cl, args, li, 1);
#endif
        }
        SEAM(p + 1);
        if (IN(p + 2)) {
            pg8::Gemm g{mixed, (const bf16*)(wb + W_OUT), M, DM, DM}; pg8::StaticOrder S; S.init(M, DM, Cl.G, Cl.blk);
            pg8::EpiF32Ssq E{y1, DM, ssq};
            for (int rep_ = 0; rep_ < GEMM_REPS; ++rep_) { int t2_ = Cl.tid; asm volatile("" : "+v"(t2_)); pg8::gemm_phase<pg8::EpiF32Ssq, pg8::StaticOrder, true, true>(Cl.lds, g, S, E, t2_); }
        }
        SEAM(p + 2);
        if (IN(p + 3)) { resid_phase(Cl, args, li == 0 ? args.in[0] : args.out, y1, args.in[2] + li * DM); }
        SEAM(p + 3);
        if (IN(p + 4)) {
            pg8::Gemm g{xb, (const bf16*)(wb + W_FF1), M, DFF, DM}; pg8::StaticOrder S; S.init(M, DFF, Cl.G, Cl.blk);
            pg8::EpiRowScaleBf16 E{fb, DFF, rinv, 1};
            for (int rep_ = 0; rep_ < GEMM_REPS; ++rep_) { int t2_ = Cl.tid; asm volatile("" : "+v"(t2_)); pg8::gemm_phase<pg8::EpiRowScaleBf16, pg8::StaticOrder, true, true>(Cl.lds, g, S, E, t2_); }
        }
        SEAM(p + 4);
        if (IN(p + 5)) {
            pg8::Gemm g{fb, (const bf16*)(wb + W_FF2), M, DM, DFF}; pg8::StaticOrder S; S.init(M, DM, Cl.G, Cl.blk);
            pg8::EpiF32Ssq E{y2, DM, ssq};
            for (int rep_ = 0; rep_ < GEMM_REPS; ++rep_) { int t2_ = Cl.tid; asm volatile("" : "+v"(t2_)); pg8::gemm_phase<pg8::EpiF32Ssq, pg8::StaticOrder, true, true>(Cl.lds, g, S, E, t2_); }
        }
        SEAM(p + 5);
        if (IN(p + 6)) { resid_phase(Cl, args, args.out, y2, args.in[13] + li * DM); }
        SEAM(p + 6);
    }
#undef IN
#undef SEAM
}

extern "C" void kernel_launch(void* const* d_in, const int* in_sizes, int n_in, void* d_out, int out_size, void* d_ws, size_t ws_size, hipStream_t stream) {
    static int grid = 0;
    if (grid == 0) {
        if (n_in != 16 || in_sizes[0] != M * DM || out_size != M * DM || ws_size < WS_END) { fprintf(stderr, "kernel_launch: unexpected shapes (n_in %d, in0 %d, out %d, ws %zu); nothing launched\n", n_in, n_in > 0 ? in_sizes[0] : -1, out_size, ws_size); grid = -1; return; }
        int dev = 0, cus = 0, per_cu = 0;
        if (hipGetDevice(&dev) != hipSuccess || hipDeviceGetAttribute(&cus, hipDeviceAttributeMultiprocessorCount, dev) != hipSuccess) { grid = -1; return; }
        if (hipFuncSetAttribute((const void*)mk_fwd, hipFuncAttributeMaxDynamicSharedMemorySize, LDS_BYTES) != hipSuccess) { fprintf(stderr, "kernel_launch: hipFuncSetAttribute failed\n"); grid = -1; return; }
        if (hipOccupancyMaxActiveBlocksPerMultiprocessor(&per_cu, (const void*)mk_fwd, NWAVES * 64, LDS_BYTES) != hipSuccess || per_cu < 1) { fprintf(stderr, "kernel_launch: occupancy query says %d\n", per_cu); per_cu = 1; }
        (void)hipGetLastError();
        grid = cus;
    }
    if (grid < 0) return;
    if (hipMemsetAsync(d_ws, 0, CTL_ZERO_BYTES, stream) != hipSuccess) { fprintf(stderr, "kernel_launch: hipMemsetAsync failed\n"); return; }
    Args a{};
    for (int i = 0; i < 16; ++i) a.in[i] = (const float*)d_in[i];
    a.out = (float*)d_out; a.ws = (unsigned char*)d_ws;
    if (N_LAUNCHES == 1) {
        a.ph_lo = 0; a.ph_hi = NPHASE;
        void* kargs[] = {&a};
        hipError_t e = hipLaunchCooperativeKernel((const void*)mk_fwd, dim3(grid), dim3(NWAVES * 64), kargs, LDS_BYTES, stream);
        if (e != hipSuccess) fprintf(stderr, "kernel_launch: cooperative launch failed: %s (grid %d)\n", hipGetErrorString(e), grid);
    } else {
        for (int k = 0; k < NPHASE; ++k) {
            a.ph_lo = k; a.ph_hi = k + 1;
            hipLaunchKernelGGL(mk_fwd, dim3(grid), dim3(NWAVES * 64), LDS_BYTES, stream, a);
        }
    }
}
```

```cpp
#include <hip/hip_runtime.h>
#include <hip/hip_cooperative_groups.h>
#include <cstdio>
#include <cstdint>
namespace cg = cooperative_groups;

#ifndef REP_GMLP
#define REP_GMLP 1
#endif
#ifndef REP_DIFF
#define REP_DIFF 1
#endif
#ifndef REP_DIL
#define REP_DIL 1
#endif
#ifndef REP_CONV
#define REP_CONV 1
#endif
#ifndef GEMM_REPS
#define GEMM_REPS 1
#endif
#ifndef MK_N_LAUNCHES
#define MK_N_LAUNCHES 1
#endif

namespace pg8 {
#define PG8_LAS __attribute__((address_space(3)))
typedef unsigned short bf16_t;
typedef short bf16x8 __attribute__((ext_vector_type(8)));
typedef float f32x4 __attribute__((ext_vector_type(4)));
typedef unsigned u32x4 __attribute__((ext_vector_type(4)));
constexpr int BM = 256, BK = 64, HALF = 128, HTB = HALF * BK * 2  , STAGE_BYTES = 8 * HTB, NXCD = 8, WGM = 8;

__host__ __device__ __forceinline__ int lds_byte(int r, int c) { const int st = (r >> 4) * 2 + (c >> 5), rr = r & 15, cc = c & 31, ob = rr * 64 + cc * 2; return st * 1024 + (ob ^ (((ob >> 9) & 1) << 5)); }
__host__ __device__ __forceinline__ void stage_rc(int b, int& R, int& C) { const int st = b / 1024, sb = b % 1024, swz = sb ^ (((sb >> 9) & 1) << 5); R = (st >> 1) * 16 + swz / 64; C = (st & 1) * 32 + (swz % 64) / 2; }
__host__ __device__ __forceinline__ int perm32(int rho) { const int n = rho >> 4, i = rho & 15; return 8 * (i >> 2) + 4 * n + (i & 3); }

struct Unit { int pm, pn; };
struct Gemm { const bf16_t* A; const bf16_t* Bt; int M, N, K; };

struct StaticOrder {
    int nM, nN, nwg, G, c;
    __host__ __device__ void init(int M, int N, int G_, int c_) { nM = M / BM; nN = N / BM; nwg = nM * nN; G = G_; c = c_; }
    __host__ __device__ bool next(int i, Unit& u) const {
        const long L = (long)i * G + c; if (L >= nwg) return false;
        int wgid = (int)L; { const int q = nwg / NXCD, r = nwg % NXCD, xcd = wgid % NXCD, off = wgid / NXCD; wgid = (xcd < r ? xcd * (q + 1) : r * (q + 1) + (xcd - r) * q) + off; }
        const int nig = WGM * nN, gid = wgid / nig, fm = gid * WGM, gsz = (nM - fm) < WGM ? (nM - fm) : WGM;
        u.pm = fm + ((wgid % nig) % gsz); u.pn = (wgid % nig) / gsz; return true;
    }
    __device__ __forceinline__ void a_ready(const Unit&) const {}
    __device__ __forceinline__ void done(const Unit&) const {}
};

__device__ __forceinline__ unsigned cvt_pk_bf16(float lo, float hi) { unsigned r; asm volatile("v_cvt_pk_bf16_f32 %0, %1, %2" : "=v"(r) : "v"(lo), "v"(hi)); return r; }

struct EpiRowScaleBf16 {
    static constexpr bool PERM = true, AFTER_DRAIN = false;
    bf16_t* O; int ldc; const float* rinv; int act;
    __device__ __forceinline__ void operator()(const f32x4 (&acc)[2][2][4][2], const Unit& u, int wr, int wc, int fr, int fq) const {
        const int row0 = u.pm * BM + wr * 64 + fr; const int col0 = u.pn * BM + wc * 32 + 8 * fq;
#pragma unroll
        for (int ai = 0; ai < 2; ++ai)
#pragma unroll
            for (int m = 0; m < 4; ++m) { const int row = row0 + ai * HALF + m * 16; const float s = rinv[row]; bf16_t* rowp = O + (size_t)row * ldc + col0;
#pragma unroll
                for (int bj = 0; bj < 2; ++bj) { f32x4 v0 = acc[ai][bj][m][0] * s, v1 = acc[ai][bj][m][1] * s;
                    if (act) {
#pragma unroll
                        for (int e = 0; e < 4; ++e) { const float a = fmaxf(v0[e], 0.f), b = fmaxf(v1[e], 0.f); v0[e] = a * a; v1[e] = b * b; } }
                    u32x4 w; w.x = cvt_pk_bf16(v0[0], v0[1]); w.y = cvt_pk_bf16(v0[2], v0[3]); w.z = cvt_pk_bf16(v1[0], v1[1]); w.w = cvt_pk_bf16(v1[2], v1[3]);
                    *(u32x4*)(rowp + bj * HALF) = w; } }
    }
};
struct EpiBf16Ssq {
    static constexpr bool PERM = true, AFTER_DRAIN = false;
    bf16_t* Y; int ldc; float* ssq;
    __device__ __forceinline__ void operator()(const f32x4 (&acc)[2][2][4][2], const Unit& u, int wr, int wc, int fr, int fq) const {
        const int row0 = u.pm * BM + wr * 64 + fr; const int col0 = u.pn * BM + wc * 32 + 8 * fq;
#pragma unroll
        for (int ai = 0; ai < 2; ++ai)
#pragma unroll
            for (int m = 0; m < 4; ++m) { const int row = row0 + ai * HALF + m * 16; bf16_t* rowp = Y + (size_t)row * ldc + col0; float s = 0.f;
#pragma unroll
                for (int bj = 0; bj < 2; ++bj) { const f32x4 v0 = acc[ai][bj][m][0], v1 = acc[ai][bj][m][1];
                    s += (v0[0] * v0[0] + v0[1] * v0[1]) + (v0[2] * v0[2] + v0[3] * v0[3]) + (v1[0] * v1[0] + v1[1] * v1[1]) + (v1[2] * v1[2] + v1[3] * v1[3]);
                    u32x4 w; w.x = cvt_pk_bf16(v0[0], v0[1]); w.y = cvt_pk_bf16(v0[2], v0[3]); w.z = cvt_pk_bf16(v1[0], v1[1]); w.w = cvt_pk_bf16(v1[2], v1[3]);
                    *(u32x4*)(rowp + bj * HALF) = w; }
                s += __shfl_xor(s, 16); s += __shfl_xor(s, 32);
                if (fq == 0) ssq[(size_t)row * 32 + u.pn * 4 + wc] = s; }
    }
};

template <class Epi, class Sched, bool ALIGN_EPI = false, bool SP2 = false>
__device__ __forceinline__ void gemm_phase(PG8_LAS unsigned char* lds, const Gemm g, const Sched& S, const Epi& E, const int tid) {
    const int wid = __builtin_amdgcn_readfirstlane(tid >> 6), lane = tid & 63, wr = wid >> 2, wc = wid & 3, fr = lane & 15, fq = lane >> 4;
    const int K = g.K, nt = K / BK;
    unsigned voffA[2], voffB[2];
#pragma unroll
    for (int i = 0; i < 2; ++i) { int R, C; stage_rc(tid * 16 + i * 8192, R, C); const int Rb = Epi::PERM ? ((R & ~31) + perm32(R & 31)) : R;
        voffA[i] = (unsigned)(R * K + C) * 2u; voffB[i] = (unsigned)(Rb * K + C) * 2u; }
    const size_t kstep = (size_t)(BK * 2);
    const size_t hstep = (size_t)HALF * K * 2;
    const size_t tstep = 2 * hstep;
    const unsigned ldsw = (unsigned)wid * 1024u;
    const int aoff = lds_byte(wr * 64 + fr, fq * 8), boff = lds_byte(wc * 32 + fr, fq * 8);
#define PG8_SA(b, h) (((b) * 2 + (h)) * HTB)
#define PG8_SB(b, h) ((4 + (b) * 2 + (h)) * HTB)
#define PG8_STAGE(bufoff, gbase, voff) do { _Pragma("unroll") for (int _i = 0; _i < 2; ++_i) \
        __builtin_amdgcn_global_load_lds((const unsigned*)((const char*)(gbase) + (voff)[_i]), (PG8_LAS unsigned*)(lds + (bufoff) + ldsw + _i * 8192), 16, 0, 0); } while (0)
#define PG8_LDA(dst, b, h) do { _Pragma("unroll") for (int m = 0; m < 4; ++m) _Pragma("unroll") for (int k = 0; k < 2; ++k) dst[m][k] = *(const PG8_LAS bf16x8*)(lds + PG8_SA(b, h) + aoff + m * 2048 + k * 1024); } while (0)
#define PG8_LDB(dst, b, h) do { _Pragma("unroll") for (int n = 0; n < 2; ++n) _Pragma("unroll") for (int k = 0; k < 2; ++k) dst[n][k] = *(const PG8_LAS bf16x8*)(lds + PG8_SB(b, h) + boff + n * 2048 + k * 1024); } while (0)
#define PG8_MMA(ai, bj, At, Bt) do { __builtin_amdgcn_s_setprio(1); _Pragma("unroll") for (int m = 0; m < 4; ++m) _Pragma("unroll") for (int n = 0; n < 2; ++n) _Pragma("unroll") for (int k = 0; k < 2; ++k) \
        acc[ai][bj][m][n] = __builtin_amdgcn_mfma_f32_16x16x32_bf16(Bt[n][k], At[m][k], acc[ai][bj][m][n], 0, 0, 0); __builtin_amdgcn_s_setprio(0); } while (0)
#define PG8_WAIT_V(n) asm volatile("s_waitcnt vmcnt(" #n ")" ::: "memory")
#define PG8_WAIT_L(n) asm volatile("s_waitcnt lgkmcnt(" #n ")" ::: "memory")
#define PG8_BAR __builtin_amdgcn_s_barrier()
#define PG8_SCHED __builtin_amdgcn_sched_barrier(0)
    Unit cur, nxt; int ui = 0;
    if (!S.next(0, cur)) return;
    f32x4 acc[2][2][4][2];
#pragma unroll
    for (int a = 0; a < 2; ++a)
#pragma unroll
        for (int b = 0; b < 2; ++b)
#pragma unroll
            for (int m = 0; m < 4; ++m)
#pragma unroll
                for (int n = 0; n < 2; ++n) acc[a][b][m][n] = (f32x4){0.f, 0.f, 0.f, 0.f};
    bf16x8 At[4][2], B0[2][2], B1[2][2];
    const char* cA = (const char*)g.A + (size_t)cur.pm * tstep; const char* cB = (const char*)g.Bt + (size_t)cur.pn * tstep;
    S.a_ready(cur);
    if constexpr (SP2) {
        PG8_STAGE(PG8_SB(0, 0), cB, voffB); PG8_STAGE(PG8_SB(0, 1), cB + hstep, voffB); PG8_STAGE(PG8_SA(0, 0), cA, voffA); PG8_STAGE(PG8_SA(0, 1), cA + hstep, voffA);
        if (wr == 1) PG8_BAR;
        PG8_WAIT_V(2); PG8_BAR;
        PG8_STAGE(PG8_SB(1, 0), cB + kstep, voffB); PG8_STAGE(PG8_SA(1, 0), cA + kstep, voffA); PG8_STAGE(PG8_SB(1, 1), cB + hstep + kstep, voffB);
        PG8_WAIT_V(6); PG8_BAR;
    } else {
        PG8_STAGE(PG8_SB(0, 0), cB, voffB); PG8_STAGE(PG8_SA(0, 0), cA, voffA); PG8_STAGE(PG8_SB(0, 1), cB + hstep, voffB); PG8_STAGE(PG8_SA(0, 1), cA + hstep, voffA);
        if (wr == 1) PG8_BAR;
        PG8_WAIT_V(4); PG8_BAR;
        PG8_STAGE(PG8_SB(1, 0), cB + kstep, voffB); PG8_STAGE(PG8_SA(1, 0), cA + kstep, voffA); PG8_STAGE(PG8_SB(1, 1), cB + hstep + kstep, voffB);
        PG8_WAIT_V(6); PG8_BAR;
    }
    for (;;) {
        const bool has_next = S.next(ui + 1, nxt);
        const char* nA = has_next ? (const char*)g.A + (size_t)nxt.pm * tstep : cA; const char* nB = has_next ? (const char*)g.Bt + (size_t)nxt.pn * tstep : cB;
        for (int t = 0; t < nt; t += 2) {
            const bool last = (t == nt - 2);
            const char* a1 = cA + (size_t)(t + 1) * kstep;
            const char* a2 = last ? nA : cA + (size_t)(t + 2) * kstep; const char* b2 = last ? nB : cB + (size_t)(t + 2) * kstep;
            const char* a3 = a2 + kstep; const char* b3 = b2 + kstep;
            if (last && has_next) S.a_ready(nxt);
            if constexpr (SP2) {
            PG8_LDB(B0, 0, 0); PG8_LDB(B1, 0, 1); PG8_SCHED; PG8_LDA(At, 0, 0); PG8_STAGE(PG8_SA(1, 1), a1 + hstep, voffA);
            PG8_WAIT_V(8); PG8_WAIT_L(0); PG8_BAR; PG8_MMA(0, 0, At, B0); PG8_MMA(0, 1, At, B1); PG8_BAR; PG8_SCHED;
            PG8_LDA(At, 0, 1); PG8_STAGE(PG8_SB(0, 0), b2, voffB); PG8_STAGE(PG8_SB(0, 1), b2 + hstep, voffB); PG8_STAGE(PG8_SA(0, 0), a2, voffA);
            PG8_WAIT_V(8); PG8_WAIT_L(0); PG8_BAR; PG8_MMA(1, 0, At, B0); PG8_MMA(1, 1, At, B1); PG8_BAR; PG8_SCHED;
            PG8_LDB(B0, 1, 0); PG8_LDB(B1, 1, 1); PG8_SCHED; PG8_LDA(At, 1, 0); PG8_STAGE(PG8_SA(0, 1), a2 + hstep, voffA);
            PG8_WAIT_V(8); PG8_WAIT_L(0); PG8_BAR; PG8_MMA(0, 0, At, B0); PG8_MMA(0, 1, At, B1); PG8_BAR; PG8_SCHED;
            PG8_LDA(At, 1, 1); PG8_STAGE(PG8_SB(1, 0), b3, voffB); PG8_STAGE(PG8_SB(1, 1), b3 + hstep, voffB); PG8_STAGE(PG8_SA(1, 0), a3, voffA);
            PG8_WAIT_V(8); PG8_WAIT_L(0); PG8_BAR; PG8_MMA(1, 0, At, B0); PG8_MMA(1, 1, At, B1); PG8_BAR; PG8_SCHED;
            } else {
            PG8_LDB(B0, 0, 0); PG8_SCHED; PG8_LDA(At, 0, 0); PG8_STAGE(PG8_SA(1, 1), a1 + hstep, voffA);
            PG8_WAIT_L(8); PG8_BAR; PG8_WAIT_L(0); PG8_MMA(0, 0, At, B0); PG8_BAR; PG8_SCHED;
            PG8_LDB(B1, 0, 1); PG8_STAGE(PG8_SB(0, 0), b2, voffB);
            PG8_BAR; PG8_WAIT_L(0); PG8_MMA(0, 1, At, B1); PG8_BAR;
            PG8_LDA(At, 0, 1); PG8_STAGE(PG8_SA(0, 0), a2, voffA);
            PG8_BAR; PG8_WAIT_L(0); PG8_MMA(1, 0, At, B0); PG8_BAR; PG8_SCHED;
            PG8_STAGE(PG8_SB(0, 1), b2 + hstep, voffB);
            PG8_WAIT_V(6); PG8_BAR; PG8_MMA(1, 1, At, B1); PG8_BAR;
            PG8_LDB(B0, 1, 0); PG8_SCHED; PG8_LDA(At, 1, 0); PG8_STAGE(PG8_SA(0, 1), a2 + hstep, voffA);
            PG8_WAIT_L(8); PG8_BAR; PG8_WAIT_L(0); PG8_MMA(0, 0, At, B0); PG8_BAR; PG8_SCHED;
            PG8_LDB(B1, 1, 1); PG8_STAGE(PG8_SB(1, 0), b3, voffB);
            PG8_BAR; PG8_WAIT_L(0); PG8_MMA(0, 1, At, B1); PG8_BAR;
            PG8_LDA(At, 1, 1); PG8_STAGE(PG8_SA(1, 0), a3, voffA);
            PG8_BAR; PG8_WAIT_L(0); PG8_MMA(1, 0, At, B0); PG8_BAR; PG8_SCHED;
            PG8_STAGE(PG8_SB(1, 1), b3 + hstep, voffB);
            PG8_WAIT_V(6); PG8_BAR; PG8_MMA(1, 1, At, B1); PG8_BAR;
            }
        }
        if constexpr (ALIGN_EPI) { if (wr == 0) PG8_BAR; }
        if constexpr (!Epi::AFTER_DRAIN) { E(acc, cur, wr, wc, fr, fq); S.done(cur); }
        if (!has_next) break;
#pragma unroll
        for (int a = 0; a < 2; ++a)
#pragma unroll
            for (int b = 0; b < 2; ++b)
#pragma unroll
                for (int m = 0; m < 4; ++m)
#pragma unroll
                    for (int n = 0; n < 2; ++n) acc[a][b][m][n] = (f32x4){0.f, 0.f, 0.f, 0.f};
        cur = nxt; cA = nA; cB = nB; ++ui;
        if constexpr (ALIGN_EPI) { if (wr == 1) PG8_BAR; }
    }
    PG8_WAIT_V(0);
    if constexpr (!ALIGN_EPI) { if (wr == 0) PG8_BAR; }
    PG8_BAR;
#undef PG8_SA
#undef PG8_SB
#undef PG8_STAGE
#undef PG8_LDA
#undef PG8_LDB
#undef PG8_MMA
#undef PG8_WAIT_V
#undef PG8_WAIT_L
#undef PG8_BAR
#undef PG8_SCHED
}
}

constexpr int NWAVES = 8;
constexpr int N_LAUNCHES = MK_N_LAUNCHES;
constexpr int DEPTH = 2, NB = 4, SEQ = 2048, DM = 2048, M = NB * SEQ, INW = 5120, DFF = 8192;
constexpr int NPHASE = 1 + 7 * DEPTH;
constexpr float NORM_EPS = 1e-6f;
constexpr float LOG2E = 1.4426950408889634f;
constexpr int C_AU = 0, C_AV = 512, C_BQ = 1024, C_BK = 1536, C_BV = 2048, C_CQ = 2560, C_CK = 3072, C_CV = 3584, C_DA = 4096, C_DG = 4608;

constexpr size_t MiB = 1u << 20;
constexpr size_t WS_RINV = 1 * MiB, WS_SSQ = 2 * MiB;
constexpr size_t WS_W = 4 * MiB, W_LAYER = 92 * MiB, W_IN = 0, W_OUT = 20 * MiB, W_FF1 = 28 * MiB, W_FF2 = 60 * MiB;
constexpr size_t WS_XB = 188 * MiB;
constexpr size_t WS_R = 220 * MiB, R_PROJ = 0, R_MIXED = 80 * MiB, R_Y1 = 112 * MiB, R_F = 0, R_Y2 = 128 * MiB;
constexpr size_t WS_END = 412 * MiB;

constexpr int RING_BYTES = 131072;
constexpr int LDS_BYTES = 147456;

#define LAS __attribute__((address_space(3)))
typedef unsigned short bf16;
typedef unsigned v4u __attribute__((ext_vector_type(4)));
typedef float f32x4 __attribute__((ext_vector_type(4)));
#define LDS_WAIT() asm volatile("s_waitcnt lgkmcnt(0)" ::: "memory")

__device__ __forceinline__ unsigned f2bf(float f) { unsigned u = __builtin_bit_cast(unsigned, f); return (u + 0x7fffu + ((u >> 16) & 1u)) >> 16; }
__device__ __forceinline__ unsigned pk2(float lo, float hi) { return f2bf(lo) | (f2bf(hi) << 16); }
__device__ __forceinline__ float bf_lo(unsigned u) { return __uint_as_float(u << 16); }
__device__ __forceinline__ float bf_hi(unsigned u) { return __uint_as_float(u & 0xffff0000u); }
__device__ __forceinline__ float bf1(bf16 h) { return __uint_as_float(((unsigned)h) << 16); }
__device__ __forceinline__ float wave_sum(float v) {
#pragma unroll
    for (int o = 1; o < 64; o <<= 1) v += __shfl_xor(v, o);
    return v;
}
__device__ __forceinline__ float gelu_tanh(float x) { const float z = 0.7978845608028654f * (x + 0.044715f * x * x * x); return x / (1.f + __expf(-2.f * z)); }
__device__ __forceinline__ float sigmoidf_(float x) { return 1.f / (1.f + __expf(-x)); }

struct Args { const float* in[16]; float* out; unsigned char* ws; int ph_lo, ph_hi; };

struct Ctx {
    int tid, lane, wave, G, blk;
    LAS unsigned char* lds;
};

__device__ __forceinline__ void p0_transpose_item(const float* W, int K, int N, bf16* WT, const float* gk, LAS float* scr, int item, int lane) {
    const int nblk = N / 64, kb = item / nblk, nb = item % nblk, k0 = 64 * kb, n0 = 64 * nb;
    const float* src = W + (size_t)(k0 + (lane >> 4)) * N + n0 + 4 * (lane & 15);
    f32x4 v[16];
#pragma unroll
    for (int i = 0; i < 16; ++i) v[i] = *(const f32x4*)(src + (size_t)(4 * i) * N);
    const int c = lane & 7;
    f32x4 g0 = (f32x4){1.f, 1.f, 1.f, 1.f}, g1 = g0;
    if (gk) { g0 = *(const f32x4*)(gk + k0 + 8 * c); g1 = *(const f32x4*)(gk + k0 + 8 * c + 4); }
#pragma unroll
    for (int i = 0; i < 16; ++i) { LAS float* d = scr + (4 * i + (lane >> 4)) * 65 + 4 * (lane & 15); d[0] = v[i].x; d[1] = v[i].y; d[2] = v[i].z; d[3] = v[i].w; }
    LDS_WAIT(); asm volatile("" ::: "memory");
#pragma unroll
    for (int j = 0; j < 8; ++j) { const int n = (lane >> 3) + 8 * j; const LAS float* sp = scr + (8 * c) * 65 + n;
        v4u o; o.x = pk2(sp[0 * 65] * g0.x, sp[1 * 65] * g0.y); o.y = pk2(sp[2 * 65] * g0.z, sp[3 * 65] * g0.w); o.z = pk2(sp[4 * 65] * g1.x, sp[5 * 65] * g1.y); o.w = pk2(sp[6 * 65] * g1.z, sp[7 * 65] * g1.w);
        *(v4u*)(WT + (size_t)(n0 + n) * K + k0 + 8 * c) = o; }
    LDS_WAIT(); asm volatile("" ::: "memory");
}

__device__ __forceinline__ void p0_prologue(const Ctx& C, const Args& a) {
    LAS float* scr = (LAS float*)(C.lds + C.wave * 16640);
    const int gw = C.blk * NWAVES + C.wave, NGW = C.G * NWAVES;
    constexpr int I_IN = (DM / 64) * (INW / 64), I_OUT = (DM / 64) * (DM / 64), I_F1 = (DM / 64) * (DFF / 64), I_F2 = (DFF / 64) * (DM / 64);
    constexpr int PER_LAYER = I_IN + I_OUT + I_F1 + I_F2;
    for (int it = gw; it < DEPTH * PER_LAYER; it += NGW) {
        const int li = it / PER_LAYER; int r = it % PER_LAYER;
        unsigned char* wb = a.ws + WS_W + (size_t)li * W_LAYER;
        if (r < I_IN) { p0_transpose_item(a.in[3] + (size_t)li * DM * INW, DM, INW, (bf16*)(wb + W_IN), a.in[1] + li * DM, scr, r, C.lane); continue; } r -= I_IN;
        if (r < I_OUT) { p0_transpose_item(a.in[11] + (size_t)li * DM * DM, DM, DM, (bf16*)(wb + W_OUT), nullptr, scr, r, C.lane); continue; } r -= I_OUT;
        if (r < I_F1) { p0_transpose_item(a.in[14] + (size_t)li * DM * DFF, DM, DFF, (bf16*)(wb + W_FF1), a.in[12] + li * DM, scr, r, C.lane); continue; } r -= I_F1;
        p0_transpose_item(a.in[15] + (size_t)li * DFF * DM, DFF, DM, (bf16*)(wb + W_FF2), nullptr, scr, r, C.lane);
    }
    if (C.blk == 0 && C.tid < 64 * DEPTH) ((unsigned*)a.ws)[C.tid] = 0u;
    const float* x = a.in[0]; bf16* xb = (bf16*)(a.ws + WS_XB); float* rinv = (float*)(a.ws + WS_RINV);
    for (int m = gw; m < M; m += NGW) {
        const f32x4* xr = (const f32x4*)(x + (size_t)m * DM) + C.lane; unsigned long long* o8 = (unsigned long long*)(xb + (size_t)m * DM) + C.lane; float s = 0.f;
#pragma unroll
        for (int j = 0; j < 8; ++j) { const f32x4 v = xr[64 * j]; const unsigned w0 = pk2(v.x, v.y), w1 = pk2(v.z, v.w);
            const float r0 = bf_lo(w0), r1 = bf_hi(w0), r2 = bf_lo(w1), r3 = bf_hi(w1); s += (r0 * r0 + r1 * r1) + (r2 * r2 + r3 * r3);
            o8[64 * j] = (unsigned long long)w0 | ((unsigned long long)w1 << 32); }
        s = wave_sum(s);
        if (C.lane == 0) rinv[m] = 1.f / sqrtf(s * (1.f / DM) + NORM_EPS);
    }
}

__device__ __forceinline__ void resid_phase(const Ctx& C, const Args& a, const bf16* y, const float* g, bool last) {
    const int gw = C.blk * NWAVES + C.wave, NGW = C.G * NWAVES;
    const float* ssq = (const float*)(a.ws + WS_SSQ); bf16* xb = (bf16*)(a.ws + WS_XB); float* rinv = (float*)(a.ws + WS_RINV);
    for (int m = gw; m < M; m += NGW) {
        float p = (C.lane < 32) ? ssq[(size_t)m * 32 + C.lane] : 0.f; p = wave_sum(p);
        const float rs = 1.f / sqrtf(p * (1.f / DM) + NORM_EPS);
        uint2* xr = (uint2*)(xb + (size_t)m * DM) + C.lane; const uint2* yr = (const uint2*)(y + (size_t)m * DM) + C.lane; const f32x4* gr = (const f32x4*)g + C.lane;
        f32x4* orow = (f32x4*)(a.out + (size_t)m * DM) + C.lane; float s = 0.f;
        uint2 xv[8], yv[8];
#pragma unroll
        for (int j = 0; j < 8; ++j) { xv[j] = xr[64 * j]; yv[j] = yr[64 * j]; }
#pragma unroll
        for (int j = 0; j < 8; ++j) { const f32x4 gv = gr[64 * j]; const f32x4 yf = (f32x4){bf_lo(yv[j].x), bf_hi(yv[j].x), bf_lo(yv[j].y), bf_hi(yv[j].y)};
            const f32x4 xf = (f32x4){bf_lo(xv[j].x), bf_hi(xv[j].x), bf_lo(xv[j].y), bf_hi(xv[j].y)}; const f32x4 v = xf + yf * rs * gv;
            if (last) orow[64 * j] = v;
            else { uint2 w; w.x = pk2(v.x, v.y); w.y = pk2(v.z, v.w); xr[64 * j] = w;
                const float r0 = bf_lo(w.x), r1 = bf_hi(w.x), r2 = bf_lo(w.y), r3 = bf_hi(w.y); s += (r0 * r0 + r1 * r1) + (r2 * r2 + r3 * r3); } }
        s = wave_sum(s);
        if (!last && C.lane == 0) rinv[m] = 1.f / sqrtf(s * (1.f / DM) + NORM_EPS);
    }
}

__device__ __forceinline__ void att_key(const bf16* kp, const bf16* vp, float bias2, const float (&q)[64], float& m, float& l, float (&o)[64]) {
    float s = 0.f;
#pragma unroll
    for (int c = 0; c < 8; ++c) { const uint4 kk = ((const uint4*)kp)[c];
        s += q[8 * c + 0] * bf_lo(kk.x) + q[8 * c + 1] * bf_hi(kk.x) + q[8 * c + 2] * bf_lo(kk.y) + q[8 * c + 3] * bf_hi(kk.y)
           + q[8 * c + 4] * bf_lo(kk.z) + q[8 * c + 5] * bf_hi(kk.z) + q[8 * c + 6] * bf_lo(kk.w) + q[8 * c + 7] * bf_hi(kk.w); }
    s += bias2;
    if (s > m) { const float al = __builtin_amdgcn_exp2f(m - s); l *= al;
#pragma unroll
        for (int d = 0; d < 64; ++d) o[d] *= al;
        m = s; }
    const float p = __builtin_amdgcn_exp2f(s - m);
    l += p;
#pragma unroll
    for (int c = 0; c < 8; ++c) { const uint4 vv = ((const uint4*)vp)[c];
        o[8 * c + 0] += p * bf_lo(vv.x); o[8 * c + 1] += p * bf_hi(vv.x); o[8 * c + 2] += p * bf_lo(vv.y); o[8 * c + 3] += p * bf_hi(vv.y);
        o[8 * c + 4] += p * bf_lo(vv.z); o[8 * c + 5] += p * bf_hi(vv.z); o[8 * c + 6] += p * bf_lo(vv.w); o[8 * c + 7] += p * bf_hi(vv.w); }
}
__device__ __forceinline__ void load_q64(const bf16* qp, float sc, float (&q)[64]) {
#pragma unroll
    for (int c = 0; c < 8; ++c) { const uint4 qq = ((const uint4*)qp)[c];
        q[8 * c + 0] = sc * bf_lo(qq.x); q[8 * c + 1] = sc * bf_hi(qq.x); q[8 * c + 2] = sc * bf_lo(qq.y); q[8 * c + 3] = sc * bf_hi(qq.y);
        q[8 * c + 4] = sc * bf_lo(qq.z); q[8 * c + 5] = sc * bf_hi(qq.z); q[8 * c + 6] = sc * bf_lo(qq.w); q[8 * c + 7] = sc * bf_hi(qq.w); }
}
__device__ __forceinline__ void store64_bf16(bf16* op, const float (&o)[64]) {
#pragma unroll
    for (int c = 0; c < 8; ++c) { v4u w; w.x = pk2(o[8 * c + 0], o[8 * c + 1]); w.y = pk2(o[8 * c + 2], o[8 * c + 3]); w.z = pk2(o[8 * c + 4], o[8 * c + 5]); w.w = pk2(o[8 * c + 6], o[8 * c + 7]);
        ((v4u*)op)[c] = w; }
}

typedef float f32x16 __attribute__((ext_vector_type(16)));
typedef short v4i16_t __attribute__((ext_vector_type(4)));
typedef short bf16x8_t __attribute__((ext_vector_type(8)));
constexpr int D_KRS = 272, D_VRS = 320, D_KB = 64 * D_KRS, D_VB = 64 * D_VRS;
constexpr int D_K0 = 0, D_K1 = D_KB, D_V0 = 2 * D_KB, D_V1 = 2 * D_KB + D_VB;
typedef float f32x2_t __attribute__((ext_vector_type(2))); typedef __bf16 bf16x2_t __attribute__((ext_vector_type(2)));
__device__ __forceinline__ unsigned cvtpk(float lo, float hi) { const f32x2_t v = {lo, hi}; const bf16x2_t b = __builtin_convertvector(v, bf16x2_t); return __builtin_bit_cast(unsigned, b); }
__device__ __forceinline__ v4i16_t tr_read(LAS unsigned char* p) { return __builtin_amdgcn_ds_read_tr16_b64_v4i16((LAS v4i16_t*)p); }

__device__ __forceinline__ void diff_unit(const Ctx& C, const Args& a, int li, int bh, int qblk, float lam, float lam_init) {
    const bf16* proj = (const bf16*)(a.ws + WS_R + R_PROJ); bf16* mixed = (bf16*)(a.ws + WS_R + R_MIXED);
    const int b = bh >> 2, h = bh & 3;
    const int lane = C.lane, r32 = lane & 31, hi = lane >> 5, map = C.wave >> 2, sl = C.wave & 3;
    const int qw0 = qblk * 128 + 32 * sl, qpos = qw0 + r32;
    const bf16* kvbase = proj + (size_t)b * SEQ * INW;
    LAS unsigned char* lds = C.lds;
    bf16x8_t qf[4];
    { const bf16* qp = kvbase + (size_t)qpos * INW + C_BQ + h * 128 + map * 64 + 8 * hi;
#pragma unroll
      for (int d0 = 0; d0 < 4; ++d0) qf[d0] = *(const bf16x8_t*)(qp + 16 * d0); }
    const float slope2 = exp2f(-8.f * (float)(3 * h + 1) / 12.f) * LOG2E; const float C2 = 0.125f * LOG2E;
    f32x16 O[4];
#pragma unroll
    for (int i = 0; i < 4; ++i)
#pragma unroll
        for (int r = 0; r < 16; ++r) O[i][r] = 0.f;
    float m = -INFINITY, l = 0.f;
    const int NT = 2 * qblk + 2;
    v4u kreg[2], vreg[2];
#define D_GLOAD(t) do { _Pragma("unroll") for (int i_ = 0; i_ < 2; ++i_) { const int id_ = C.tid + 512 * i_, row_ = id_ >> 4, ch_ = id_ & 15; \
        const bf16* rp_ = kvbase + (size_t)((t) * 64 + row_) * INW + h * 128 + ch_ * 8; kreg[i_] = *(const v4u*)(rp_ + C_BK); vreg[i_] = *(const v4u*)(rp_ + C_BV); } } while (0)
#define D_LSTORE(buf) do { _Pragma("unroll") for (int i_ = 0; i_ < 2; ++i_) { const int id_ = C.tid + 512 * i_, row_ = id_ >> 4, ch_ = id_ & 15; \
        *(LAS v4u*)(lds + ((buf) ? D_K1 : D_K0) + row_ * D_KRS + ch_ * 16) = kreg[i_]; *(LAS v4u*)(lds + ((buf) ? D_V1 : D_V0) + row_ * D_VRS + ch_ * 16) = vreg[i_]; } } while (0)
    D_GLOAD(0); D_LSTORE(0);
    __syncthreads();
    const int koff = r32 * D_KRS + map * 128 + hi * 16;
    const int voff = (4 * hi + ((lane & 15) >> 2)) * D_VRS + (16 * ((lane >> 4) & 1) + 4 * (lane & 3)) * 2;
    for (int t = 0; t < NT; ++t) {
        const int buf = t & 1;
        if (t + 1 < NT) D_GLOAD(t + 1);
        const int k0 = t * 64;
        if (k0 <= qw0 + 31) {
            LAS unsigned char* kb_ = lds + (buf ? D_K1 : D_K0) + koff; LAS unsigned char* vb_ = lds + (buf ? D_V1 : D_V0) + voff;
            f32x16 p0, p1;
#pragma unroll
            for (int r = 0; r < 16; ++r) { p0[r] = 0.f; p1[r] = 0.f; }
#pragma unroll
            for (int d0 = 0; d0 < 4; ++d0) { const bf16x8_t kf0 = *(LAS bf16x8_t*)(kb_ + d0 * 32), kf1 = *(LAS bf16x8_t*)(kb_ + 32 * D_KRS + d0 * 32);
                p0 = __builtin_amdgcn_mfma_f32_32x32x16_bf16(kf0, qf[d0], p0, 0, 0, 0); p1 = __builtin_amdgcn_mfma_f32_32x32x16_bf16(kf1, qf[d0], p1, 0, 0, 0); }
            v4i16_t tq0[3], tq1[3];
            tq0[0] = tr_read(vb_); tq1[0] = tr_read(vb_ + 8 * D_VRS); tq0[1] = tr_read(vb_ + 64); tq1[1] = tr_read(vb_ + 64 + 8 * D_VRS);
            const float bb = slope2 * (float)(k0 + 4 * hi - qpos);
#pragma unroll
            for (int r = 0; r < 16; ++r) { const int c = (r & 3) + 8 * (r >> 2); p0[r] = fmaf(p0[r], C2, bb + slope2 * (float)c); p1[r] = fmaf(p1[r], C2, bb + slope2 * (float)(c + 32)); }
            if (k0 + 63 > qw0) {
#pragma unroll
                for (int r = 0; r < 16; ++r) { const int kp = k0 + 4 * hi + (r & 3) + 8 * (r >> 2); if (kp > qpos) p0[r] = -INFINITY; if (kp + 32 > qpos) p1[r] = -INFINITY; }
            }
            float tmax = fmaxf(p0[0], p1[0]);
#pragma unroll
            for (int r = 1; r < 16; ++r) tmax = fmaxf(tmax, fmaxf(p0[r], p1[r]));
            tmax = fmaxf(tmax, __shfl_xor(tmax, 32));
            const float mn = fmaxf(m, tmax), al = __builtin_amdgcn_exp2f(m - mn); m = mn;
            float rs = 0.f;
#pragma unroll
            for (int r = 0; r < 16; ++r) { p0[r] = __builtin_amdgcn_exp2f(p0[r] - mn); p1[r] = __builtin_amdgcn_exp2f(p1[r] - mn); rs += p0[r] + p1[r]; }
            l = l * al + rs;
#pragma unroll
            for (int i = 0; i < 4; ++i)
#pragma unroll
                for (int r = 0; r < 16; ++r) O[i][r] *= al;
            bf16x8_t pb[4];
            { v4u w;
              w.x = cvtpk(p0[0], p0[1]); w.y = cvtpk(p0[2], p0[3]); w.z = cvtpk(p0[4], p0[5]); w.w = cvtpk(p0[6], p0[7]); pb[0] = __builtin_bit_cast(bf16x8_t, w);
              w.x = cvtpk(p0[8], p0[9]); w.y = cvtpk(p0[10], p0[11]); w.z = cvtpk(p0[12], p0[13]); w.w = cvtpk(p0[14], p0[15]); pb[1] = __builtin_bit_cast(bf16x8_t, w);
              w.x = cvtpk(p1[0], p1[1]); w.y = cvtpk(p1[2], p1[3]); w.z = cvtpk(p1[4], p1[5]); w.w = cvtpk(p1[6], p1[7]); pb[2] = __builtin_bit_cast(bf16x8_t, w);
              w.x = cvtpk(p1[8], p1[9]); w.y = cvtpk(p1[10], p1[11]); w.z = cvtpk(p1[12], p1[13]); w.w = cvtpk(p1[14], p1[15]); pb[3] = __builtin_bit_cast(bf16x8_t, w); }
            __builtin_amdgcn_sched_barrier(0);
#pragma unroll
            for (int x = 0; x < 16; ++x) {
                if (x + 2 < 16) { LAS unsigned char* vp = vb_ + (16 * ((x + 2) >> 2)) * D_VRS + ((x + 2) & 3) * 64; tq0[(x + 2) % 3] = tr_read(vp); tq1[(x + 2) % 3] = tr_read(vp + 8 * D_VRS); }
                __builtin_amdgcn_sched_barrier(0);
                { const v4i16_t t0 = tq0[x % 3], t1 = tq1[x % 3];
                  const bf16x8_t vf = (bf16x8_t){t0[0], t0[1], t0[2], t0[3], t1[0], t1[1], t1[2], t1[3]};
                  O[x & 3] = __builtin_amdgcn_mfma_f32_32x32x16_bf16(vf, pb[x >> 2], O[x & 3], 0, 0, 0); }
                __builtin_amdgcn_sched_barrier(0);
            }
        }
        if (t + 1 < NT) D_LSTORE(buf ^ 1);
        __syncthreads();
    }
#undef D_GLOAD
#undef D_LSTORE
    l += __shfl_xor(l, 32);
    { const float inv = 1.f / l;
#pragma unroll
      for (int i = 0; i < 4; ++i)
#pragma unroll
          for (int r = 0; r < 16; ++r) O[i][r] *= inv; }
    LAS float* X = (LAS float*)lds;
    if (map == 1) {
#pragma unroll
        for (int i = 0; i < 4; ++i)
#pragma unroll
            for (int r = 0; r < 16; ++r) X[(sl * 64 + i * 16 + r) * 64 + lane] = O[i][r];
    }
    __syncthreads();
    if (map == 0) {
        float ss = 0.f;
#pragma unroll
        for (int i = 0; i < 4; ++i)
#pragma unroll
            for (int r = 0; r < 16; ++r) { const float o = O[i][r] - lam * X[(sl * 64 + i * 16 + r) * 64 + lane]; O[i][r] = o; ss += o * o; }
        ss += __shfl_xor(ss, 32);
        const float rr = (1.f - lam_init) / sqrtf(ss * (1.f / 128.f) + NORM_EPS);
        const float* sg = a.in[7] + li * 128;
        bf16* orow = mixed + ((size_t)b * SEQ + qpos) * DM + 512 + h * 128;
#pragma unroll
        for (int i = 0; i < 4; ++i)
#pragma unroll
            for (int g = 0; g < 4; ++g) { const int d = i * 32 + 8 * g + 4 * hi; const f32x4 gv = *(const f32x4*)(sg + d);
                uint2 wv; wv.x = pk2(O[i][4 * g] * rr * gv.x, O[i][4 * g + 1] * rr * gv.y); wv.y = pk2(O[i][4 * g + 2] * rr * gv.z, O[i][4 * g + 3] * rr * gv.w);
                *(uint2*)(orow + d) = wv; }
    }
    __syncthreads();
}

constexpr int DL_VRS = 192, DL_VST = 32 * DL_VRS;
constexpr size_t DP_O = 0, DP_M = 32 * MiB, DP_L = 33 * MiB;
__device__ __forceinline__ void dil_tile(const Ctx& C, const bf16* kvb, int dil, int rc, int J, int c_lo, int c_hi, float slope2, LAS unsigned char* vst, float& m, float& l, f32x16 (&O)[2]) {
    const int lane = C.lane, r32 = lane & 31, hi = lane >> 5;
    const size_t t = (size_t)dil * J + rc;
    bf16x8_t qf[4];
#pragma unroll
    for (int d0 = 0; d0 < 4; ++d0) qf[d0] = *(const bf16x8_t*)(kvb + t * INW + C_CQ + 16 * d0 + 8 * hi);
    m = -INFINITY; l = 0.f;
#pragma unroll
    for (int i = 0; i < 2; ++i)
#pragma unroll
        for (int r = 0; r < 16; ++r) O[i][r] = 0.f;
    const float sd2 = slope2 * (float)dil, C2 = 0.125f * LOG2E;
    const int voff = (4 * hi + ((lane & 15) >> 2)) * DL_VRS + (16 * ((lane >> 4) & 1) + 4 * (lane & 3)) * 2;
    bf16x8_t kf[4]; v4u vr[4];
#define DL_LOADKV(c) do { const bf16* kp_ = kvb + ((size_t)dil * (32 * (c) + r32) + rc) * INW + C_CK + 8 * hi; \
        _Pragma("unroll") for (int d0 = 0; d0 < 4; ++d0) kf[d0] = *(const bf16x8_t*)(kp_ + 16 * d0); \
        _Pragma("unroll") for (int i_ = 0; i_ < 4; ++i_) { const int p_ = lane + 64 * i_; vr[i_] = *(const v4u*)(kvb + ((size_t)dil * (32 * (c) + (p_ >> 3)) + rc) * INW + C_CV + (p_ & 7) * 8); } } while (0)
    DL_LOADKV(c_lo);
    for (int c = c_lo; c <= c_hi; ++c) {
        bf16x8_t kc[4]; v4u vc[4];
#pragma unroll
        for (int i = 0; i < 4; ++i) { kc[i] = kf[i]; vc[i] = vr[i]; }
        if (c < c_hi) DL_LOADKV(c + 1);
#pragma unroll
        for (int i = 0; i < 4; ++i) { const int p_ = lane + 64 * i; *(LAS v4u*)(vst + (p_ >> 3) * DL_VRS + (p_ & 7) * 16) = vc[i]; }
        f32x16 p;
#pragma unroll
        for (int r = 0; r < 16; ++r) p[r] = 0.f;
#pragma unroll
        for (int d0 = 0; d0 < 4; ++d0) p = __builtin_amdgcn_mfma_f32_32x32x16_bf16(kc[d0], qf[d0], p, 0, 0, 0);
        const int jb = 32 * c + 4 * hi;
        const float bb = sd2 * (float)(jb - J);
#pragma unroll
        for (int r = 0; r < 16; ++r) p[r] = fmaf(p[r], C2, bb + sd2 * (float)((r & 3) + 8 * (r >> 2)));
#pragma unroll
        for (int r = 0; r < 16; ++r) { const int jk = jb + (r & 3) + 8 * (r >> 2); if (jk > J || jk < J - 128) p[r] = -INFINITY; }
        float tmax = p[0];
#pragma unroll
        for (int r = 1; r < 16; ++r) tmax = fmaxf(tmax, p[r]);
        tmax = fmaxf(tmax, __shfl_xor(tmax, 32));
        const float mn = fmaxf(m, tmax), al = __builtin_amdgcn_exp2f(m - mn); m = mn;
        float rs = 0.f;
#pragma unroll
        for (int r = 0; r < 16; ++r) { p[r] = __builtin_amdgcn_exp2f(p[r] - mn); rs += p[r]; }
        l = l * al + rs;
#pragma unroll
        for (int i = 0; i < 2; ++i)
#pragma unroll
            for (int r = 0; r < 16; ++r) O[i][r] *= al;
        bf16x8_t pb[2];
        { v4u w;
          w.x = cvtpk(p[0], p[1]); w.y = cvtpk(p[2], p[3]); w.z = cvtpk(p[4], p[5]); w.w = cvtpk(p[6], p[7]); pb[0] = __builtin_bit_cast(bf16x8_t, w);
          w.x = cvtpk(p[8], p[9]); w.y = cvtpk(p[10], p[11]); w.z = cvtpk(p[12], p[13]); w.w = cvtpk(p[14], p[15]); pb[1] = __builtin_bit_cast(bf16x8_t, w); }
        asm volatile("s_waitcnt lgkmcnt(0)" ::: "memory");
#pragma unroll
        for (int ks = 0; ks < 2; ++ks)
#pragma unroll
            for (int i = 0; i < 2; ++i) { LAS unsigned char* vp = vst + voff + (16 * ks) * DL_VRS + i * 64;
                const v4i16_t t0 = tr_read(vp), t1 = tr_read(vp + 8 * DL_VRS);
                const bf16x8_t vf = (bf16x8_t){t0[0], t0[1], t0[2], t0[3], t1[0], t1[1], t1[2], t1[3]};
                O[i] = __builtin_amdgcn_mfma_f32_32x32x16_bf16(vf, pb[ks], O[i], 0, 0, 0); }
        asm volatile("s_waitcnt lgkmcnt(0)" ::: "memory");
    }
#undef DL_LOADKV
    l += __shfl_xor(l, 32);
}
__device__ __forceinline__ void dil_unit(const Ctx& C, const Args& a, int b, int h, int sg) {
    const bf16* proj = (const bf16*)(a.ws + WS_R + R_PROJ); bf16* mixed = (bf16*)(a.ws + WS_R + R_MIXED);
    unsigned char* part = a.ws + WS_R + R_Y1;
    float* PO = (float*)(part + DP_O); float* PM = (float*)(part + DP_M); float* PL = (float*)(part + DP_L);
    const bf16* kvb = proj + (size_t)b * SEQ * INW + h * 64;
    const int lane = C.lane, r32 = lane & 31, hi = lane >> 5;
    const int sidx = 3 * (h >> 1) + 1 + (h & 1);
    const float slope2 = exp2f(-8.f * (float)(sidx + 1) / 12.f) * LOG2E;
    LAS unsigned char* vst = C.lds + C.wave * DL_VST;
    const size_t qbase = (size_t)(b * 8 + h) * SEQ;
    float m, l; f32x16 O[2];
#pragma unroll 1
    for (int i = 0; i < 2; ++i) { const int tl = C.wave * 2 + i, pat = tl >> 3, k = tl & 7;
        const int dil = pat ? 4 : 1, rc = pat ? (k >> 1) : 0, J0 = pat ? (64 * sg + 32 * (k & 1)) : (256 * sg + 32 * k);
        const int c_hi = J0 >> 5, c_lo = (c_hi - 4 < 0) ? 0 : c_hi - 4;
        dil_tile(C, kvb, dil, rc, J0 + r32, c_lo, c_hi, slope2, vst, m, l, O);
        const size_t idx = (size_t)pat * 65536 + qbase + (size_t)dil * (J0 + r32) + rc;
#pragma unroll
        for (int ii = 0; ii < 2; ++ii)
#pragma unroll
            for (int g = 0; g < 4; ++g) *(f32x4*)(PO + idx * 64 + ii * 32 + 8 * g + 4 * hi) = (f32x4){O[ii][4 * g], O[ii][4 * g + 1], O[ii][4 * g + 2], O[ii][4 * g + 3]};
        if (hi == 0) { PM[idx] = m; PL[idx] = l; } }
    __syncthreads();
#pragma unroll 1
    for (int i = 0; i < 2; ++i) { const int rc = C.wave * 2 + i, J = 16 * sg + (r32 & 15);
        dil_tile(C, kvb, 16, rc, J, 0, (16 * sg + 15) >> 5, slope2, vst, m, l, O);
        const size_t t = (size_t)16 * J + rc, i1 = qbase + t, i2 = 65536 + qbase + t;
        const float m1 = PM[i1], l1 = PL[i1], m2 = PM[i2], l2 = PL[i2];
        const float mx = fmaxf(m, fmaxf(m1, m2));
        const float w3 = __builtin_amdgcn_exp2f(m - mx), w1 = __builtin_amdgcn_exp2f(m1 - mx), w2 = __builtin_amdgcn_exp2f(m2 - mx);
        const float inv = 1.f / (w3 * l + w1 * l1 + w2 * l2);
        bf16* orow = mixed + ((size_t)b * SEQ + t) * DM + 1024 + h * 64;
        if (r32 < 16) {
#pragma unroll
        for (int ii = 0; ii < 2; ++ii)
#pragma unroll
            for (int g = 0; g < 4; ++g) { const int d = ii * 32 + 8 * g + 4 * hi; const f32x4 o1 = *(const f32x4*)(PO + i1 * 64 + d), o2 = *(const f32x4*)(PO + i2 * 64 + d);
                const float v0 = (w3 * O[ii][4 * g] + w1 * o1.x + w2 * o2.x) * inv, v1 = (w3 * O[ii][4 * g + 1] + w1 * o1.y + w2 * o2.y) * inv;
                const float v2 = (w3 * O[ii][4 * g + 2] + w1 * o1.z + w2 * o2.z) * inv, v3 = (w3 * O[ii][4 * g + 3] + w1 * o1.w + w2 * o2.w) * inv;
                uint2 wv; wv.x = pk2(v0, v1); wv.y = pk2(v2, v3); *(uint2*)(orow + d) = wv; }
        } }
    __syncthreads();
}

constexpr int G_VRS = 1088;
__device__ __forceinline__ void gmlp_unit(const Ctx& C, const Args& a, int li, int unit) {
    const bf16* proj = (const bf16*)(a.ws + WS_R + R_PROJ); bf16* mixed = (bf16*)(a.ws + WS_R + R_MIXED);
    const size_t row0 = (size_t)unit * 128;
    LAS unsigned char* vn = C.lds;
    const int lane = C.lane, r32 = lane & 31, hi = lane >> 5;
#pragma unroll 4
    for (int tt = 0; tt < 16; ++tt) { const int t = C.wave * 16 + tt;
        const v4u vv = *(const v4u*)(proj + (row0 + t) * INW + C_AV + lane * 8);
        float v[8] = {bf_lo(vv.x), bf_hi(vv.x), bf_lo(vv.y), bf_hi(vv.y), bf_lo(vv.z), bf_hi(vv.z), bf_lo(vv.w), bf_hi(vv.w)}; float s = 0.f;
#pragma unroll
        for (int e = 0; e < 8; ++e) { v[e] = gelu_tanh(v[e]); s += v[e]; }
        const float mean = wave_sum(s) * (1.f / 512.f); float s2 = 0.f;
#pragma unroll
        for (int e = 0; e < 8; ++e) { v[e] -= mean; s2 += v[e] * v[e]; }
        const float rstd = 1.f / sqrtf(wave_sum(s2) * (1.f / 512.f) + NORM_EPS);
        v4u w; w.x = pk2(v[0] * rstd, v[1] * rstd); w.y = pk2(v[2] * rstd, v[3] * rstd); w.z = pk2(v[4] * rstd, v[5] * rstd); w.w = pk2(v[6] * rstd, v[7] * rstd);
        *(LAS v4u*)(vn + t * G_VRS + lane * 16) = w; }
    __syncthreads();
    const int g = C.wave;
    const float* W = a.in[4] + ((size_t)li * 8 + g) * 128 * 128; const float* bs = a.in[5] + ((size_t)li * 8 + g) * 128;
    const int aoff = (8 * hi + ((lane & 15) >> 2)) * G_VRS + (g * 64 + 16 * ((lane >> 4) & 1) + 4 * (lane & 3)) * 2;
#pragma unroll
    for (int tb = 0; tb < 4; ++tb) {
        f32x16 acc[2];
#pragma unroll
        for (int i = 0; i < 2; ++i)
#pragma unroll
            for (int r = 0; r < 16; ++r) acc[i][r] = 0.f;
        const int t = tb * 32 + r32;
        const float* wrow = W + t * 128 + 8 * hi;
        f32x4 wf[2 * (2 * 3 + 2)];
#pragma unroll
        for (int ks = 0; ks <= 2 * tb + 1; ++ks) { wf[2 * ks] = *(const f32x4*)(wrow + 16 * ks); wf[2 * ks + 1] = *(const f32x4*)(wrow + 16 * ks + 4); }
#pragma unroll
        for (int ks = 0; ks <= 2 * tb + 1; ++ks) { const int s0 = 16 * ks, sb = s0 + 8 * hi;
            const f32x4 w0 = wf[2 * ks], w1 = wf[2 * ks + 1];
            float wv[8] = {w0.x, w0.y, w0.z, w0.w, w1.x, w1.y, w1.z, w1.w};
#pragma unroll
            for (int j = 0; j < 8; ++j) if (sb + j > t) wv[j] = 0.f;
            v4u wp; wp.x = cvtpk(wv[0], wv[1]); wp.y = cvtpk(wv[2], wv[3]); wp.z = cvtpk(wv[4], wv[5]); wp.w = cvtpk(wv[6], wv[7]);
            const bf16x8_t bfrag = __builtin_bit_cast(bf16x8_t, wp);
#pragma unroll
            for (int i = 0; i < 2; ++i) { LAS unsigned char* vp = vn + aoff + s0 * G_VRS + i * 64;
                const v4i16_t t0 = tr_read(vp), t1 = tr_read(vp + 4 * G_VRS);
                const bf16x8_t af = (bf16x8_t){t0[0], t0[1], t0[2], t0[3], t1[0], t1[1], t1[2], t1[3]};
                acc[i] = __builtin_amdgcn_mfma_f32_32x32x16_bf16(af, bfrag, acc[i], 0, 0, 0); } }
        const float bt = bs[t];
        const bf16* urow = proj + (row0 + t) * INW + C_AU + g * 64; bf16* orow = mixed + (row0 + t) * DM + g * 64;
#pragma unroll
        for (int i = 0; i < 2; ++i)
#pragma unroll
            for (int gq = 0; gq < 4; ++gq) { const int d = i * 32 + 8 * gq + 4 * hi; const uint2 uu = *(const uint2*)(urow + d);
                const float u0 = gelu_tanh(bf_lo(uu.x)), u1 = gelu_tanh(bf_hi(uu.x)), u2 = gelu_tanh(bf_lo(uu.y)), u3 = gelu_tanh(bf_hi(uu.y));
                uint2 wv2; wv2.x = pk2(u0 * (acc[i][4 * gq] + bt), u1 * (acc[i][4 * gq + 1] + bt)); wv2.y = pk2(u2 * (acc[i][4 * gq + 2] + bt), u3 * (acc[i][4 * gq + 3] + bt));
                *(uint2*)(orow + d) = wv2; }
    }
    __syncthreads();
}

__device__ __forceinline__ void conv_unit(const Ctx& C, const Args& a, int li, int unit) {
    const bf16* proj = (const bf16*)(a.ws + WS_R + R_PROJ); bf16* mixed = (bf16*)(a.ws + WS_R + R_MIXED);
    const int b = unit >> 6, t0 = (unit & 63) * 32, c = C.tid;
    LAS float* hs = (LAS float*)C.lds;
    const float* cw = a.in[8] + (size_t)li * 31 * 512;
#pragma unroll
    for (int k = 0; k < 8; ++k) { const int i = C.wave + 8 * k; const int s = t0 - 30 + i;
        if (i < 62) { float hv[8];
#pragma unroll
            for (int e = 0; e < 8; ++e) hv[e] = 0.f;
            if (s >= 0) { const bf16* pr = proj + ((size_t)b * SEQ + s) * INW + C.lane * 8; const v4u av = *(const v4u*)(pr + C_DA), gv = *(const v4u*)(pr + C_DG);
                hv[0] = bf_lo(av.x) * sigmoidf_(bf_lo(gv.x)); hv[1] = bf_hi(av.x) * sigmoidf_(bf_hi(gv.x)); hv[2] = bf_lo(av.y) * sigmoidf_(bf_lo(gv.y)); hv[3] = bf_hi(av.y) * sigmoidf_(bf_hi(gv.y));
                hv[4] = bf_lo(av.z) * sigmoidf_(bf_lo(gv.z)); hv[5] = bf_hi(av.z) * sigmoidf_(bf_hi(gv.z)); hv[6] = bf_lo(av.w) * sigmoidf_(bf_lo(gv.w)); hv[7] = bf_hi(av.w) * sigmoidf_(bf_hi(gv.w)); }
            *(LAS f32x4*)(hs + i * 512 + C.lane * 8) = (f32x4){hv[0], hv[1], hv[2], hv[3]}; *(LAS f32x4*)(hs + i * 512 + C.lane * 8 + 4) = (f32x4){hv[4], hv[5], hv[6], hv[7]}; } }
    float w[31];
#pragma unroll
    for (int k = 0; k < 31; ++k) w[k] = cw[k * 512 + c];
    const float bd = a.in[9][li * 512 + c];
    __syncthreads();
#pragma unroll 1
    for (int j = 0; j < 32; ++j) { float acc = bd;
#pragma unroll
        for (int k = 0; k < 31; ++k) acc += w[k] * hs[(j + k) * 512 + c];
        hs[j * 512 + c] = acc; }
    __syncthreads();
    const float* ng = a.in[10] + li * 512 + C.lane * 8;
#pragma unroll 1
    for (int jj = 0; jj < 4; ++jj) { const int j = C.wave * 4 + jj; float v[8]; float ss = 0.f;
#pragma unroll
        for (int e = 0; e < 8; ++e) { v[e] = hs[j * 512 + C.lane * 8 + e]; ss += v[e] * v[e]; }
        const float r = 1.f / sqrtf(wave_sum(ss) * (1.f / 512.f) + NORM_EPS);
#pragma unroll
        for (int e = 0; e < 8; ++e) { const float hn = v[e] * r * ng[e]; v[e] = hn * sigmoidf_(hn); }
        v4u wv; wv.x = pk2(v[0], v[1]); wv.y = pk2(v[2], v[3]); wv.z = pk2(v[4], v[5]); wv.w = pk2(v[6], v[7]);
        *(v4u*)(mixed + ((size_t)b * SEQ + t0 + j) * DM + 1536 + C.lane * 8) = wv; }
    __syncthreads();
}

#define LAUNDER(Cn, Cs) Ctx Cn = Cs; { int t_ = Cs.tid; asm volatile("" : "+v"(t_)); Cn.tid = t_; Cn.lane = t_ & 63; }
__device__ __forceinline__ int next_item(const Ctx& C, unsigned* ctr) {
    volatile LAS unsigned* word = (volatile LAS unsigned*)(C.lds + LDS_BYTES - 16);
    __syncthreads();
    if (C.tid == 0) *word = atomicAdd(ctr, 1u);
    __syncthreads();
    return (int)*word;
}
__device__ __forceinline__ void mixer_phase(const Ctx& C0, const Args& a, int li, int qsel = 0) {
    const float* lp = a.in[6] + li * 256;
    const float d01 = wave_sum(lp[C0.lane] * lp[64 + C0.lane]), d23 = wave_sum(lp[128 + C0.lane] * lp[192 + C0.lane]);
    const float lam_init = 0.8f - 0.6f * expf(-0.3f * (float)li);
    const float lam = expf(d01) - expf(d23) + lam_init;
    unsigned* ctr = (unsigned*)a.ws + 64 * li + 32 * qsel;
    for (;;) {
        int it = next_item(C0, ctr);
        if (it >= 256 + 256 + 64 + 256) break;
        Ctx C = C0; { int t_ = C0.tid; asm volatile("" : "+v"(t_)); C.tid = t_; C.lane = t_ & 63; }
        if (it < 256) { for (int rp_ = 0; rp_ < REP_DIL; ++rp_) { LAUNDER(Cr, C); dil_unit(Cr, a, it >> 6, (it >> 3) & 7, it & 7); } continue; } it -= 256;
        if (it < 256) { for (int rp_ = 0; rp_ < REP_DIFF; ++rp_) { LAUNDER(Cr, C); diff_unit(Cr, a, li, it & 15, 15 - (it >> 4), lam, lam_init); } continue; } it -= 256;
        if (it < 64) { for (int rp_ = 0; rp_ < REP_GMLP; ++rp_) { LAUNDER(Cr, C); gmlp_unit(Cr, a, li, it); } continue; } it -= 64;
        for (int rp_ = 0; rp_ < REP_CONV; ++rp_) { LAUNDER(Cr, C); conv_unit(Cr, a, li, it); }
    }
}

#define XB_TMO      128
#define XB_XCNT(j)  (256  + 64 * (j))
#define XB_XSUB(j)  (1280 + 64 * (j))
#define XB_XGEN(j)  (2304 + 64 * (j))
#define XB_TOP      3328
#define XB_TOPGEN   3392
#define XCD_BAR_WORDS 3456
#define XB_SPIN_CAP (1u << 18)
__device__ __forceinline__ unsigned xb_ld(unsigned* p)              { return __hip_atomic_load(p, __ATOMIC_RELAXED, __HIP_MEMORY_SCOPE_AGENT); }
__device__ __forceinline__ unsigned xb_add(unsigned* p, unsigned v) { return __hip_atomic_fetch_add(p, v, __ATOMIC_RELAXED, __HIP_MEMORY_SCOPE_AGENT); }
__device__ __forceinline__ unsigned xb_xcc_id() { return (unsigned)__builtin_amdgcn_s_getreg((3 << 11) | 20) & 0xFu; }
#define XB_SPIN(cond, bar) do { unsigned _sp = 0; while (cond) { __builtin_amdgcn_s_sleep(1); \
    if ((++_sp & 255u) == 0u) { if (xb_ld(&(bar)[XB_TMO])) break; if (_sp > XB_SPIN_CAP) { atomicAdd(&(bar)[XB_TMO], 1u); break; } } } } while (0)
struct XcdBarrier { unsigned* bar; unsigned x; volatile LAS unsigned* st; };
__device__ __forceinline__ XcdBarrier xcd_barrier_post(unsigned* bar, volatile LAS unsigned* st) {
    XcdBarrier b; b.bar = bar; b.x = xb_xcc_id(); b.st = st;
    if (threadIdx.x == 0) (void)xb_add(&bar[XB_XCNT(b.x)], 1u);
    return b;
}
__device__ __forceinline__ void xcd_barrier_complete(unsigned* bar, unsigned x, unsigned& nloc, unsigned& nx) {
    const unsigned G = gridDim.x * gridDim.y * gridDim.z;
    unsigned sum, cnt, mine, sp = 0u;
    for (;;) {
        sum = 0u; cnt = 0u; mine = 0u;
#pragma unroll
        for (unsigned j = 0; j < 16; ++j) { const unsigned c = xb_ld(&bar[XB_XCNT(j)]); sum += c; cnt += (c > 0u) ? 1u : 0u; mine = (j == x) ? c : mine; }
        if (sum == G) break;
        __builtin_amdgcn_s_sleep(1);
        if ((++sp & 255u) == 0u) { if (xb_ld(&bar[XB_TMO])) break; if (sp > XB_SPIN_CAP) { atomicAdd(&bar[XB_TMO], 1u); break; } }
    }
    nloc = mine > 0u ? mine : 1u; nx = cnt > 0u ? cnt : 1u;
}
__device__ __forceinline__ void xcd_barrier(const XcdBarrier& b) {
    asm volatile("s_waitcnt vmcnt(0)" ::: "memory");
    __syncthreads();
    if (threadIdx.x == 0) {
        unsigned* bar = b.bar;
        __builtin_amdgcn_s_waitcnt(0);
        unsigned nloc = b.st[0], nx = b.st[1];
        if (nloc == 0u) { xcd_barrier_complete(bar, b.x, nloc, nx); b.st[0] = nloc; b.st[1] = nx; }
        const unsigned old = xb_add(&bar[XB_XSUB(b.x)], 1u);
        const unsigned gen = old / nloc;
        if (old + 1u == (gen + 1u) * nloc) {
            __builtin_amdgcn_fence(__ATOMIC_RELEASE, "agent");
            asm volatile("s_waitcnt vmcnt(0)" ::: "memory");
            const unsigned og = xb_add(&bar[XB_TOP], 1u);
            const unsigned tg = og / nx;
            if (og + 1u == (tg + 1u) * nx) xb_add(&bar[XB_TOPGEN], 1u);
            else XB_SPIN(xb_ld(&bar[XB_TOPGEN]) == tg, bar);
            __builtin_amdgcn_fence(__ATOMIC_ACQUIRE, "agent");
            xb_add(&bar[XB_XGEN(b.x)], 1u);
            asm volatile("s_waitcnt vmcnt(0)" ::: "memory");
        } else {
            XB_SPIN(xb_ld(&bar[XB_XGEN(b.x)]) == gen, bar);
            __builtin_amdgcn_fence(__ATOMIC_ACQUIRE, "agent");
            asm volatile("s_waitcnt vmcnt(0)" ::: "memory");
        }
    }
    __syncthreads();
}
constexpr size_t WS_BAR = 65536;
constexpr size_t CTL_ZERO_BYTES = 131072;

__global__ void __launch_bounds__(NWAVES * 64, 2) mk_fwd(Args args) {
    extern __shared__ __attribute__((aligned(16))) unsigned char lds[];
    Ctx C; C.tid = threadIdx.x; C.lane = C.tid & 63; C.wave = __builtin_amdgcn_readfirstlane(C.tid >> 6); C.G = gridDim.x; C.blk = blockIdx.x; C.lds = (LAS unsigned char*)lds;
    const int lo = args.ph_lo, hi = args.ph_hi;
    unsigned char* ws = args.ws;
    float* rinv = (float*)(ws + WS_RINV); float* ssq = (float*)(ws + WS_SSQ);
    bf16* xb = (bf16*)(ws + WS_XB); bf16* proj = (bf16*)(ws + WS_R + R_PROJ); bf16* mixed = (bf16*)(ws + WS_R + R_MIXED);
    float* y1 = (float*)(ws + WS_R + R_Y1); float* y2 = (float*)(ws + WS_R + R_Y2); bf16* fb = (bf16*)(ws + WS_R + R_F);
#define IN(k) (lo <= (k) && (k) < hi)
    { volatile LAS unsigned* st_ = (volatile LAS unsigned*)((LAS unsigned char*)lds + LDS_BYTES - 32); if (threadIdx.x < 2) st_[threadIdx.x] = 0u; }
    __syncthreads();
    const XcdBarrier xbar = xcd_barrier_post((unsigned*)(ws + WS_BAR), (volatile LAS unsigned*)((LAS unsigned char*)lds + LDS_BYTES - 32));
#define SEAM(k) do { if (IN(k) && IN((k) + 1)) { if (args.ph_hi > NPHASE) cg::this_grid().sync(); else xcd_barrier(xbar); } } while (0)
    if (IN(0)) { p0_prologue(C, args); }
    SEAM(0);
    for (int li = 0; li < DEPTH; ++li) {
        const int p = 1 + 7 * li;
        unsigned char* wb = ws + WS_W + (size_t)li * W_LAYER;
        asm volatile("" : "+s"(wb), "+s"(xb), "+s"(proj), "+s"(mixed), "+s"(y1), "+s"(y2), "+s"(fb), "+s"(rinv), "+s"(ssq));
        Ctx Cl; { int t_ = threadIdx.x, b_ = blockIdx.x, g_ = gridDim.x; asm volatile("" : "+v"(t_), "+s"(b_), "+s"(g_));
            Cl.tid = t_; Cl.lane = t_ & 63; Cl.wave = __builtin_amdgcn_readfirstlane(t_ >> 6); Cl.G = g_; Cl.blk = b_; Cl.lds = (LAS unsigned char*)lds; }
        if (IN(p + 0)) {
            pg8::Gemm g{xb, (const bf16*)(wb + W_IN), M, INW, DM}; pg8::StaticOrder S; S.init(M, INW, Cl.G, Cl.blk);
            pg8::EpiRowScaleBf16 E{proj, INW, rinv, 0};
            for (int rep_ = 0; rep_ < GEMM_REPS; ++rep_) { int t2_ = Cl.tid; asm volatile("" : "+v"(t2_)); pg8::gemm_phase<pg8::EpiRowScaleBf16, pg8::StaticOrder, true, true>(Cl.lds, g, S, E, t2_); }
        }
        SEAM(p + 0);
        if (IN(p + 1)) { mixer_phase(Cl, args, li);
#ifdef PROBE_MIX2
            cg::this_grid().sync(); mixer_phase(Cl, args, li, 1);
#endif
        }
        SEAM(p + 1);
        if (IN(p + 2)) {
            pg8::Gemm g{mixed, (const bf16*)(wb + W_OUT), M, DM, DM}; pg8::StaticOrder S; S.init(M, DM, Cl.G, Cl.blk);
            pg8::EpiBf16Ssq E{(bf16*)y1, DM, ssq};
            for (int rep_ = 0; rep_ < GEMM_REPS; ++rep_) { int t2_ = Cl.tid; asm volatile("" : "+v"(t2_)); pg8::gemm_phase<pg8::EpiBf16Ssq, pg8::StaticOrder, true, true>(Cl.lds, g, S, E, t2_); }
        }
        SEAM(p + 2);
        if (IN(p + 3)) { resid_phase(Cl, args, (const bf16*)y1, args.in[2] + li * DM, false); }
        SEAM(p + 3);
        if (IN(p + 4)) {
            pg8::Gemm g{xb, (const bf16*)(wb + W_FF1), M, DFF, DM}; pg8::StaticOrder S; S.init(M, DFF, Cl.G, Cl.blk);
            pg8::EpiRowScaleBf16 E{fb, DFF, rinv, 1};
            for (int rep_ = 0; rep_ < GEMM_REPS; ++rep_) { int t2_ = Cl.tid; asm volatile("" : "+v"(t2_)); pg8::gemm_phase<pg8::EpiRowScaleBf16, pg8::StaticOrder, true, true>(Cl.lds, g, S, E, t2_); }
        }
        SEAM(p + 4);
        if (IN(p + 5)) {
            pg8::Gemm g{fb, (const bf16*)(wb + W_FF2), M, DM, DFF}; pg8::StaticOrder S; S.init(M, DM, Cl.G, Cl.blk);
            pg8::EpiBf16Ssq E{(bf16*)y2, DM, ssq};
            for (int rep_ = 0; rep_ < GEMM_REPS; ++rep_) { int t2_ = Cl.tid; asm volatile("" : "+v"(t2_)); pg8::gemm_phase<pg8::EpiBf16Ssq, pg8::StaticOrder, true, true>(Cl.lds, g, S, E, t2_); }
        }
        SEAM(p + 5);
        if (IN(p + 6)) { resid_phase(Cl, args, (const bf16*)y2, args.in[13] + li * DM, li == DEPTH - 1); }
        SEAM(p + 6);
    }
#undef IN
#undef SEAM
}

extern "C" void kernel_launch(void* const* d_in, const int* in_sizes, int n_in, void* d_out, int out_size, void* d_ws, size_t ws_size, hipStream_t stream) {
    static int grid = 0;
    if (grid == 0) {
        if (n_in != 16 || in_sizes[0] != M * DM || out_size != M * DM || ws_size < WS_END) { fprintf(stderr, "kernel_launch: unexpected shapes (n_in %d, in0 %d, out %d, ws %zu); nothing launched\n", n_in, n_in > 0 ? in_sizes[0] : -1, out_size, ws_size); grid = -1; return; }
        int dev = 0, cus = 0, per_cu = 0;
        if (hipGetDevice(&dev) != hipSuccess || hipDeviceGetAttribute(&cus, hipDeviceAttributeMultiprocessorCount, dev) != hipSuccess) { grid = -1; return; }
        if (hipFuncSetAttribute((const void*)mk_fwd, hipFuncAttributeMaxDynamicSharedMemorySize, LDS_BYTES) != hipSuccess) { fprintf(stderr, "kernel_launch: hipFuncSetAttribute failed\n"); grid = -1; return; }
        if (hipOccupancyMaxActiveBlocksPerMultiprocessor(&per_cu, (const void*)mk_fwd, NWAVES * 64, LDS_BYTES) != hipSuccess || per_cu < 1) { fprintf(stderr, "kernel_launch: occupancy query says %d\n", per_cu); per_cu = 1; }
        (void)hipGetLastError();
        grid = cus;
    }
    if (grid < 0) return;
    if (hipMemsetAsync(d_ws, 0, CTL_ZERO_BYTES, stream) != hipSuccess) { fprintf(stderr, "kernel_launch: hipMemsetAsync failed\n"); return; }
    Args a{};
    for (int i = 0; i < 16; ++i) a.in[i] = (const float*)d_in[i];
    a.out = (float*)d_out; a.ws = (unsigned char*)d_ws;
    if (N_LAUNCHES == 1) {
        a.ph_lo = 0; a.ph_hi = NPHASE;
        void* kargs[] = {&a};
        hipError_t e = hipLaunchCooperativeKernel((const void*)mk_fwd, dim3(grid), dim3(NWAVES * 64), kargs, LDS_BYTES, stream);
        if (e != hipSuccess) fprintf(stderr, "kernel_launch: cooperative launch failed: %s (grid %d)\n", hipGetErrorString(e), grid);
    } else {
        for (int k = 0; k < NPHASE; ++k) {
            a.ph_lo = k; a.ph_hi = k + 1;
            hipLaunchKernelGGL(mk_fwd, dim3(grid), dim3(NWAVES * 64), LDS_BYTES, stream, a);
        }
    }
}
```
